# Optimizing an MI355X kernel written in HIP

```python
import math
import jax, jax.numpy as jnp
from jax import lax
import numpy as np

D_MODEL = 1024
BATCH = 2
SEQ = 8192
DEPTH = 2

N_EVEN = (DEPTH + 1) // 2
N_ODD = DEPTH // 2

SSD_HEADS = 16
SSD_HEAD_DIM = 64
SSD_INNER = SSD_HEADS * SSD_HEAD_DIM
SSD_GROUPS = 2
SSD_STATE = 128
SSD_CHUNK = 128
SSD_CONV_DIM = SSD_INNER + 2 * SSD_GROUPS * SSD_STATE
CONV_WIDTH = 4
LRU_HEADS = 16
LRU_WIDTH = D_MODEL
LRU_BLOCK = LRU_WIDTH // LRU_HEADS
LRU_C = 8.0
IN_SPLITS = (SSD_INNER,
             SSD_INNER + SSD_CONV_DIM,
             SSD_INNER + SSD_CONV_DIM + SSD_HEADS,
             SSD_INNER + SSD_CONV_DIM + SSD_HEADS + LRU_WIDTH)
IN_COLS = IN_SPLITS[-1] + LRU_WIDTH
MIX_WIDTH = SSD_INNER + LRU_WIDTH
DIFF_HEADS = 8
DIFF_HEAD_DIM = 64
ROPE_DIM = DIFF_HEAD_DIM // 4
ROPE_THETA = 500000.0
Q_BLOCK = 128
D_FF = 4 * D_MODEL
ALPHA = (2 * DEPTH) ** 0.25
BETA = (8 * DEPTH) ** -0.25
EPS = 1e-5

kernel_name = "hybrid_ssd_rglru_diffattn_deepnorm"


def layer_norm(x, g, b):
    xf = x.astype(jnp.float32)
    mu = jnp.mean(xf, axis=-1, keepdims=True)
    var = jnp.mean(jnp.square(xf - mu), axis=-1, keepdims=True)
    return ((xf - mu) * lax.rsqrt(var + EPS)).astype(x.dtype) * g + b


def rms_normalize(x):
    xf = x.astype(jnp.float32)
    return (xf * lax.rsqrt(jnp.mean(jnp.square(xf), axis=-1, keepdims=True) + EPS)).astype(x.dtype)


def causal_conv(x, w, b):
    y = lax.conv_general_dilated(x, w[:, None, :], window_strides=(1,),
                                 padding=[(CONV_WIDTH - 1, 0)],
                                 dimension_numbers=('NWC', 'WIO', 'NWC'),
                                 feature_group_count=x.shape[-1])
    return y + b


def ssd_chunked(x, dt, a, bmat, cmat):
    bsz, s, h, p = x.shape
    g, n = bmat.shape[-2], bmat.shape[-1]
    r = h // g
    nc, l = s // SSD_CHUNK, SSD_CHUNK
    xdt = (x * dt[..., None]).reshape(bsz, nc, l, g, r, p)
    adt = (dt * a).reshape(bsz, nc, l, g, r).transpose(0, 3, 4, 1, 2)
    bc = bmat.reshape(bsz, nc, l, g, n)
    cc = cmat.reshape(bsz, nc, l, g, n)
    a_cum = jnp.cumsum(adt, axis=-1)
    causal = jnp.tril(jnp.ones((l, l), dtype=bool))
    seg = a_cum[..., :, None] - a_cum[..., None, :]
    decay = jnp.exp(jnp.where(causal, seg, -jnp.inf))
    cb = jnp.einsum('bclgn,bcsgn->bgcls', cc, bc)
    y_diag = jnp.einsum('bgcls,bgrcls,bcsgrp->bclgrp', cb, decay, xdt)
    decay_states = jnp.exp(a_cum[..., -1:] - a_cum)
    states = jnp.einsum('bcsgn,bgrcs,bcsgrp->bcgrpn', bc, decay_states, xdt)
    chunk_decay = jnp.exp(a_cum[..., -1])

    def step(hs, inp):
        st, dec = inp
        return dec[..., None, None] * hs + st, hs

    h0 = jnp.zeros(states.shape[:1] + states.shape[2:], states.dtype)
    _, prev = lax.scan(step, h0, (jnp.moveaxis(states, 1, 0), jnp.moveaxis(chunk_decay, 3, 0)))
    prev = jnp.moveaxis(prev, 0, 1)
    y_off = jnp.einsum('bclgn,bcgrpn,bgrcl->bclgrp', cc, prev, jnp.exp(a_cum))
    return (y_diag + y_off).reshape(bsz, s, h, p)


def rg_lru(x, w_a, b_a, w_x, b_x, lam):
    bsz, s, _ = x.shape
    xb = x.reshape(bsz, s, LRU_HEADS, LRU_BLOCK)
    r = jax.nn.sigmoid(jnp.einsum('bshi,hij->bshj', xb, w_a) + b_a).reshape(bsz, s, LRU_WIDTH)
    i = jax.nn.sigmoid(jnp.einsum('bshi,hij->bshj', xb, w_x) + b_x).reshape(bsz, s, LRU_WIDTH)
    log_a = (-LRU_C * r * jax.nn.softplus(-lam)).astype(jnp.float32)
    a = jnp.exp(log_a)
    mult = jnp.sqrt(jnp.maximum(-jnp.expm1(2.0 * log_a), 0.0))
    u = mult * (i * x).astype(jnp.float32)

    def combine(c1, c2):
        a1, b1 = c1
        a2, b2 = c2
        return a1 * a2, a2 * b1 + b2

    _, hs = lax.associative_scan(combine, (a, u), axis=1)
    return hs.astype(x.dtype)


def ssd_lru_mixer(x, w_in, ssm_conv_w, ssm_conv_b, dt_bias, a_log, d_skip, ssm_norm_w,
                  lru_conv_w, lru_conv_b, lru_w_a, lru_b_a, lru_w_x, lru_b_x, lru_lambda, w_out):
    bsz, s, _ = x.shape
    proj = x @ w_in
    z, xbc, dt_raw, gate_lru, x_lru = jnp.split(proj, IN_SPLITS, axis=-1)
    xbc = jax.nn.silu(causal_conv(xbc, ssm_conv_w, ssm_conv_b))
    xs, bm, cm = jnp.split(xbc, (SSD_INNER, SSD_INNER + SSD_GROUPS * SSD_STATE), axis=-1)
    dt = jax.nn.softplus(dt_raw + dt_bias)
    a = -jnp.exp(a_log)
    xh = xs.reshape(bsz, s, SSD_HEADS, SSD_HEAD_DIM)
    y = ssd_chunked(xh, dt, a, bm.reshape(bsz, s, SSD_GROUPS, SSD_STATE),
                    cm.reshape(bsz, s, SSD_GROUPS, SSD_STATE))
    y = (y + d_skip[:, None] * xh).reshape(bsz, s, SSD_INNER) * jax.nn.silu(z)
    y_a = rms_normalize(y.reshape(bsz, s, SSD_GROUPS, SSD_INNER // SSD_GROUPS)).reshape(bsz, s, SSD_INNER) * ssm_norm_w
    xl = causal_conv(x_lru, lru_conv_w, lru_conv_b)
    y_b = rg_lru(xl, lru_w_a, lru_b_a, lru_w_x, lru_b_x, lru_lambda) * jax.nn.gelu(gate_lru)
    return jnp.concatenate([y_a, y_b], axis=-1) @ w_out


def partial_rope(t, cos, sin):
    half = ROPE_DIM // 2
    t1, t2, rest = t[..., :half], t[..., half:ROPE_DIM], t[..., ROPE_DIM:]
    return jnp.concatenate([t1 * cos - t2 * sin, t2 * cos + t1 * sin, rest], axis=-1)


def diff_attention(x, positions, w_qkv, lq1, lk1, lq2, lk2, subln_w, w_out, lambda_init):
    bsz, s, _ = x.shape
    q, k, v = jnp.split(x @ w_qkv, 3, axis=-1)
    q = q.reshape(bsz, s, DIFF_HEADS, 2, DIFF_HEAD_DIM)
    k = k.reshape(bsz, s, DIFF_HEADS, 2, DIFF_HEAD_DIM)
    v = v.reshape(bsz, s, DIFF_HEADS, 2 * DIFF_HEAD_DIM)
    inv_freq = ROPE_THETA ** (-jnp.arange(0, ROPE_DIM, 2, dtype=jnp.float32) / ROPE_DIM)
    ang = positions.astype(jnp.float32)[..., None] * inv_freq
    cos = jnp.cos(ang)[:, :, None, None, :].astype(x.dtype)
    sin = jnp.sin(ang)[:, :, None, None, :].astype(x.dtype)
    q = partial_rope(q, cos, sin) * (DIFF_HEAD_DIM ** -0.5)
    k = partial_rope(k, cos, sin)
    lam = (jnp.exp(jnp.sum(lq1.astype(jnp.float32) * lk1.astype(jnp.float32)))
           - jnp.exp(jnp.sum(lq2.astype(jnp.float32) * lk2.astype(jnp.float32))) + lambda_init)
    nb = s // Q_BLOCK
    qb = q.reshape(bsz, nb, Q_BLOCK, DIFF_HEADS, 2, DIFF_HEAD_DIM).transpose(1, 0, 2, 3, 4, 5)
    key_pos = jnp.arange(s)

    def attend(args):
        qblk, start = args
        sc = jnp.einsum('bqhcd,bkhcd->bhcqk', qblk, k).astype(jnp.float32)
        qpos = start + jnp.arange(Q_BLOCK)
        sc = jnp.where(key_pos[None, :] <= qpos[:, None], sc, -jnp.inf)
        p = jax.nn.softmax(sc, axis=-1)
        attn = p[:, :, 0] - lam * p[:, :, 1]
        return jnp.einsum('bhqk,bkhe->bqhe', attn.astype(v.dtype), v)

    o = lax.map(attend, (qb, jnp.arange(nb) * Q_BLOCK))
    o = o.transpose(1, 0, 2, 3, 4).reshape(bsz, s, DIFF_HEADS, 2 * DIFF_HEAD_DIM)
    o = rms_normalize(o) * subln_w * (1.0 - lambda_init)
    return o.reshape(bsz, s, DIFF_HEADS * 2 * DIFF_HEAD_DIM) @ w_out


def sq_relu_mlp(x, w1, w2):
    return jnp.square(jax.nn.relu(x @ w1)) @ w2


def setup_inputs(seed: int = 0) -> dict:
    key = jax.random.key(seed)
    ks = jax.random.split(key, 40)

    def nrm(k, shape, scale):
        return jax.random.normal(k, shape, jnp.float32) * scale

    x = jax.random.normal(ks[0], (BATCH, SEQ, D_MODEL), jnp.float32)
    positions = jnp.broadcast_to(jnp.arange(SEQ, dtype=jnp.int32), (BATCH, SEQ))
    dt0 = jnp.exp(jax.random.uniform(ks[4], (N_EVEN, SSD_HEADS), jnp.float32,
                                     math.log(1e-3), math.log(1e-1)))
    lru_p = jax.random.uniform(ks[14], (N_EVEN, LRU_WIDTH), jnp.float32, 0.9, 0.999) ** (1.0 / LRU_C)
    return {
        "x": x,
        "positions": positions,
        "ssm_w_in": nrm(ks[1], (N_EVEN, D_MODEL, IN_COLS), D_MODEL ** -0.5),
        "ssm_conv_w": nrm(ks[2], (N_EVEN, CONV_WIDTH, SSD_CONV_DIM), CONV_WIDTH ** -0.5),
        "ssm_conv_b": nrm(ks[3], (N_EVEN, SSD_CONV_DIM), 0.02),
        "ssm_dt_bias": dt0 + jnp.log(-jnp.expm1(-dt0)),
        "ssm_a_log": jnp.log(jax.random.uniform(ks[5], (N_EVEN, SSD_HEADS), jnp.float32, 1.0, 16.0)),
        "ssm_d": 1.0 + nrm(ks[6], (N_EVEN, SSD_HEADS), 0.02),
        "ssm_norm_w": 1.0 + nrm(ks[7], (N_EVEN, SSD_INNER), 0.02),
        "lru_conv_w": nrm(ks[8], (N_EVEN, CONV_WIDTH, LRU_WIDTH), CONV_WIDTH ** -0.5),
        "lru_conv_b": nrm(ks[9], (N_EVEN, LRU_WIDTH), 0.02),
        "lru_w_a": nrm(ks[10], (N_EVEN, LRU_HEADS, LRU_BLOCK, LRU_BLOCK), LRU_BLOCK ** -0.5),
        "lru_b_a": nrm(ks[11], (N_EVEN, LRU_HEADS, LRU_BLOCK), 0.02),
        "lru_w_x": nrm(ks[12], (N_EVEN, LRU_HEADS, LRU_BLOCK, LRU_BLOCK), LRU_BLOCK ** -0.5),
        "lru_b_x": nrm(ks[13], (N_EVEN, LRU_HEADS, LRU_BLOCK), 0.02),
        "lru_lambda": jnp.log(lru_p) - jnp.log1p(-lru_p),
        "mix_w_out": nrm(ks[15], (N_EVEN, MIX_WIDTH, D_MODEL), BETA * MIX_WIDTH ** -0.5),
        "attn_w_qkv": nrm(ks[16], (N_ODD, D_MODEL, 3 * DIFF_HEADS * 2 * DIFF_HEAD_DIM), D_MODEL ** -0.5),
        "attn_lq1": nrm(ks[17], (N_ODD, DIFF_HEAD_DIM), 0.1),
        "attn_lk1": nrm(ks[18], (N_ODD, DIFF_HEAD_DIM), 0.1),
        "attn_lq2": nrm(ks[19], (N_ODD, DIFF_HEAD_DIM), 0.1),
        "attn_lk2": nrm(ks[20], (N_ODD, DIFF_HEAD_DIM), 0.1),
        "attn_subln_w": 1.0 + nrm(ks[21], (N_ODD, 2 * DIFF_HEAD_DIM), 0.02),
        "attn_w_out": nrm(ks[22], (N_ODD, DIFF_HEADS * 2 * DIFF_HEAD_DIM, D_MODEL),
                          BETA * (DIFF_HEADS * 2 * DIFF_HEAD_DIM) ** -0.5),
        "ln1_g": 1.0 + nrm(ks[23], (DEPTH, D_MODEL), 0.02),
        "ln1_b": nrm(ks[24], (DEPTH, D_MODEL), 0.02),
        "ff_w1": nrm(ks[25], (DEPTH, D_MODEL, D_FF), D_MODEL ** -0.5),
        "ff_w2": nrm(ks[26], (DEPTH, D_FF, D_MODEL), BETA * D_FF ** -0.5),
        "ln2_g": 1.0 + nrm(ks[27], (DEPTH, D_MODEL), 0.02),
        "ln2_b": nrm(ks[28], (DEPTH, D_MODEL), 0.02),
    }


def reference(x, positions, ssm_w_in, ssm_conv_w, ssm_conv_b, ssm_dt_bias, ssm_a_log, ssm_d,
              ssm_norm_w, lru_conv_w, lru_conv_b, lru_w_a, lru_b_a, lru_w_x, lru_b_x, lru_lambda,
              mix_w_out, attn_w_qkv, attn_lq1, attn_lk1, attn_lq2, attn_lk2, attn_subln_w,
              attn_w_out, ln1_g, ln1_b, ff_w1, ff_w2, ln2_g, ln2_b):
    for layer in range(DEPTH):
        i = layer // 2
        if layer % 2 == 0:
            mix = ssd_lru_mixer(x, ssm_w_in[i], ssm_conv_w[i], ssm_conv_b[i], ssm_dt_bias[i],
                                ssm_a_log[i], ssm_d[i], ssm_norm_w[i], lru_conv_w[i], lru_conv_b[i],
                                lru_w_a[i], lru_b_a[i], lru_w_x[i], lru_b_x[i], lru_lambda[i],
                                mix_w_out[i])
        else:
            lambda_init = 0.8 - 0.6 * math.exp(-0.3 * layer)
            mix = diff_attention(x, positions, attn_w_qkv[i], attn_lq1[i], attn_lk1[i],
                                 attn_lq2[i], attn_lk2[i], attn_subln_w[i], attn_w_out[i],
                                 lambda_init)
        x = layer_norm(ALPHA * x + mix, ln1_g[layer], ln1_b[layer])
        x = layer_norm(ALPHA * x + sq_relu_mlp(x, ff_w1[layer], ff_w2[layer]), ln2_g[layer], ln2_b[layer])
    return x
```

```cpp
#include <hip/hip_runtime.h>
#include <hip/hip_cooperative_groups.h>
#include <cstdio>
#include <cstdint>
#include <cmath>
namespace cg = cooperative_groups;
namespace pg8 {
#define PG8_LAS __attribute__((address_space(3)))
typedef unsigned short bf16_t;
typedef short bf16x8 __attribute__((ext_vector_type(8)));
typedef float f32x4 __attribute__((ext_vector_type(4)));
typedef unsigned u32x4 __attribute__((ext_vector_type(4)));
constexpr int BM = 256, BK = 64, HALF = 128, HTB = HALF * BK * 2  , STAGE_BYTES = 8 * HTB, NXCD = 8, WGM = 8;

__host__ __device__ __forceinline__ int lds_byte(int r, int c) { const int st = (r >> 4) * 2 + (c >> 5), rr = r & 15, cc = c & 31, ob = rr * 64 + cc * 2; return st * 1024 + (ob ^ (((ob >> 9) & 1) << 5)); }
__host__ __device__ __forceinline__ void stage_rc(int b, int& R, int& C) { const int st = b / 1024, sb = b % 1024, swz = sb ^ (((sb >> 9) & 1) << 5); R = (st >> 1) * 16 + swz / 64; C = (st & 1) * 32 + (swz % 64) / 2; }
__host__ __device__ __forceinline__ int perm32(int rho) { const int n = rho >> 4, i = rho & 15; return 8 * (i >> 2) + 4 * n + (i & 3); }

struct Unit { int pm, pn; };
struct Gemm { const bf16_t* A; const bf16_t* Bt; int M, N, K; };

struct StaticOrder {
    int nM, nN, nwg, G, c;
    __host__ __device__ void init(int M, int N, int G_, int c_) { nM = M / BM; nN = N / BM; nwg = nM * nN; G = G_; c = c_; }
    __host__ __device__ bool next(int i, Unit& u) const {
        const long L = (long)i * G + c; if (L >= nwg) return false;
        int wgid = (int)L; { const int q = nwg / NXCD, r = nwg % NXCD, xcd = wgid % NXCD, off = wgid / NXCD; wgid = (xcd < r ? xcd * (q + 1) : r * (q + 1) + (xcd - r) * q) + off; }
        const int nig = WGM * nN, gid = wgid / nig, fm = gid * WGM, gsz = (nM - fm) < WGM ? (nM - fm) : WGM;
        u.pm = fm + ((wgid % nig) % gsz); u.pn = (wgid % nig) / gsz; return true;
    }
    __device__ __forceinline__ void a_ready(const Unit&) const {}
    __device__ __forceinline__ void done(const Unit&) const {}
};

__device__ __forceinline__ unsigned cvt_pk_bf16(float lo, float hi) { unsigned r; asm volatile("v_cvt_pk_bf16_f32 %0, %1, %2" : "=v"(r) : "v"(lo), "v"(hi)); return r; }
typedef float f32x2 __attribute__((ext_vector_type(2)));
template <class Epi, class Sched, bool ALIGN_EPI = false, bool SP2 = false>
__device__ __forceinline__ void gemm_phase(PG8_LAS unsigned char* lds, const Gemm g, const Sched& S, const Epi& E) {
    int tid_o = threadIdx.x; asm volatile("" : "+v"(tid_o));
    const int tid = tid_o, wid = __builtin_amdgcn_readfirstlane(tid >> 6), lane = tid & 63, wr = wid >> 2, wc = wid & 3, fr = lane & 15, fq = lane >> 4;
    const int K = g.K, nt = K / BK;
    unsigned voffA[2], voffB[2];
#pragma unroll
    for (int i = 0; i < 2; ++i) { int R, C; stage_rc(tid * 16 + i * 8192, R, C); const int Rb = Epi::PERM ? ((R & ~31) + perm32(R & 31)) : R;
        voffA[i] = (unsigned)(R * K + C) * 2u; voffB[i] = (unsigned)(Rb * K + C) * 2u; }
    const size_t kstep = (size_t)(BK * 2);
    const size_t hstep = (size_t)HALF * K * 2;
    const size_t tstep = 2 * hstep;
    const unsigned ldsw = (unsigned)wid * 1024u;
    const int aoff = lds_byte(wr * 64 + fr, fq * 8), boff = lds_byte(wc * 32 + fr, fq * 8);
#define PG8_SA(b, h) (((b) * 2 + (h)) * HTB)
#define PG8_SB(b, h) ((4 + (b) * 2 + (h)) * HTB)
#define PG8_STAGE(bufoff, gbase, voff) do { _Pragma("unroll") for (int _i = 0; _i < 2; ++_i) \
        __builtin_amdgcn_global_load_lds((const unsigned*)((const char*)(gbase) + (voff)[_i]), (PG8_LAS unsigned*)(lds + (bufoff) + ldsw + _i * 8192), 16, 0, 0); } while (0)
#define PG8_LDA(dst, b, h) do { _Pragma("unroll") for (int m = 0; m < 4; ++m) _Pragma("unroll") for (int k = 0; k < 2; ++k) dst[m][k] = *(const PG8_LAS bf16x8*)(lds + PG8_SA(b, h) + aoff + m * 2048 + k * 1024); } while (0)
#define PG8_LDB(dst, b, h) do { _Pragma("unroll") for (int n = 0; n < 2; ++n) _Pragma("unroll") for (int k = 0; k < 2; ++k) dst[n][k] = *(const PG8_LAS bf16x8*)(lds + PG8_SB(b, h) + boff + n * 2048 + k * 1024); } while (0)
#define PG8_MMA(ai, bj, At, Bt) do { __builtin_amdgcn_s_setprio(1); _Pragma("unroll") for (int m = 0; m < 4; ++m) _Pragma("unroll") for (int n = 0; n < 2; ++n) _Pragma("unroll") for (int k = 0; k < 2; ++k) \
        acc[ai][bj][m][n] = __builtin_amdgcn_mfma_f32_16x16x32_bf16(Bt[n][k], At[m][k], acc[ai][bj][m][n], 0, 0, 0); __builtin_amdgcn_s_setprio(0); } while (0)
#define PG8_WAIT_V(n) asm volatile("s_waitcnt vmcnt(" #n ")" ::: "memory")
#define PG8_WAIT_L(n) asm volatile("s_waitcnt lgkmcnt(" #n ")" ::: "memory")
#define PG8_BAR __builtin_amdgcn_s_barrier()
#define PG8_SCHED __builtin_amdgcn_sched_barrier(0)
    Unit cur, nxt; int ui = 0;
    if (!S.next(0, cur)) return;
    f32x4 acc[2][2][4][2];
#pragma unroll
    for (int a = 0; a < 2; ++a)
#pragma unroll
        for (int b = 0; b < 2; ++b)
#pragma unroll
            for (int m = 0; m < 4; ++m)
#pragma unroll
                for (int n = 0; n < 2; ++n) acc[a][b][m][n] = (f32x4){0.f, 0.f, 0.f, 0.f};
    bf16x8 At[4][2], B0[2][2], B1[2][2];
    const char* cA = (const char*)g.A + (size_t)cur.pm * tstep; const char* cB = (const char*)g.Bt + (size_t)cur.pn * tstep;
    S.a_ready(cur);
    if constexpr (SP2) {
        PG8_STAGE(PG8_SB(0, 0), cB, voffB); PG8_STAGE(PG8_SB(0, 1), cB + hstep, voffB); PG8_STAGE(PG8_SA(0, 0), cA, voffA); PG8_STAGE(PG8_SA(0, 1), cA + hstep, voffA);
        if (wr == 1) PG8_BAR;
        PG8_WAIT_V(2); PG8_BAR;
        PG8_STAGE(PG8_SB(1, 0), cB + kstep, voffB); PG8_STAGE(PG8_SA(1, 0), cA + kstep, voffA); PG8_STAGE(PG8_SB(1, 1), cB + hstep + kstep, voffB);
        PG8_WAIT_V(6); PG8_BAR;
    } else {
        PG8_STAGE(PG8_SB(0, 0), cB, voffB); PG8_STAGE(PG8_SA(0, 0), cA, voffA); PG8_STAGE(PG8_SB(0, 1), cB + hstep, voffB); PG8_STAGE(PG8_SA(0, 1), cA + hstep, voffA);
        if (wr == 1) PG8_BAR;
        PG8_WAIT_V(4); PG8_BAR;
        PG8_STAGE(PG8_SB(1, 0), cB + kstep, voffB); PG8_STAGE(PG8_SA(1, 0), cA + kstep, voffA); PG8_STAGE(PG8_SB(1, 1), cB + hstep + kstep, voffB);
        PG8_WAIT_V(6); PG8_BAR;
    }
    for (;;) {
        const bool has_next = S.next(ui + 1, nxt);
        const char* nA = has_next ? (const char*)g.A + (size_t)nxt.pm * tstep : cA; const char* nB = has_next ? (const char*)g.Bt + (size_t)nxt.pn * tstep : cB;
        for (int t = 0; t < nt; t += 2) {
            const bool last = (t == nt - 2);
            const char* a1 = cA + (size_t)(t + 1) * kstep;
            const char* a2 = last ? nA : cA + (size_t)(t + 2) * kstep; const char* b2 = last ? nB : cB + (size_t)(t + 2) * kstep;
            const char* a3 = a2 + kstep; const char* b3 = b2 + kstep;
            if (last && has_next) S.a_ready(nxt);
            if constexpr (SP2) {
            PG8_LDB(B0, 0, 0); PG8_LDB(B1, 0, 1); PG8_SCHED; PG8_LDA(At, 0, 0); PG8_STAGE(PG8_SA(1, 1), a1 + hstep, voffA);
            PG8_WAIT_V(8); PG8_WAIT_L(0); PG8_BAR; PG8_MMA(0, 0, At, B0); PG8_MMA(0, 1, At, B1); PG8_BAR; PG8_SCHED;
            PG8_LDA(At, 0, 1); PG8_STAGE(PG8_SB(0, 0), b2, voffB); PG8_STAGE(PG8_SB(0, 1), b2 + hstep, voffB); PG8_STAGE(PG8_SA(0, 0), a2, voffA);
            PG8_WAIT_V(8); PG8_WAIT_L(0); PG8_BAR; PG8_MMA(1, 0, At, B0); PG8_MMA(1, 1, At, B1); PG8_BAR; PG8_SCHED;
            PG8_LDB(B0, 1, 0); PG8_LDB(B1, 1, 1); PG8_SCHED; PG8_LDA(At, 1, 0); PG8_STAGE(PG8_SA(0, 1), a2 + hstep, voffA);
            PG8_WAIT_V(8); PG8_WAIT_L(0); PG8_BAR; PG8_MMA(0, 0, At, B0); PG8_MMA(0, 1, At, B1); PG8_BAR; PG8_SCHED;
            PG8_LDA(At, 1, 1); PG8_STAGE(PG8_SB(1, 0), b3, voffB); PG8_STAGE(PG8_SB(1, 1), b3 + hstep, voffB); PG8_STAGE(PG8_SA(1, 0), a3, voffA);
            PG8_WAIT_V(8); PG8_WAIT_L(0); PG8_BAR; PG8_MMA(1, 0, At, B0); PG8_MMA(1, 1, At, B1); PG8_BAR; PG8_SCHED;
            } else {
            PG8_LDB(B0, 0, 0); PG8_SCHED; PG8_LDA(At, 0, 0); PG8_STAGE(PG8_SA(1, 1), a1 + hstep, voffA);
            PG8_WAIT_L(8); PG8_BAR; PG8_WAIT_L(0); PG8_MMA(0, 0, At, B0); PG8_BAR; PG8_SCHED;
            PG8_LDB(B1, 0, 1); PG8_STAGE(PG8_SB(0, 0), b2, voffB);
            PG8_BAR; PG8_WAIT_L(0); PG8_MMA(0, 1, At, B1); PG8_BAR;
            PG8_LDA(At, 0, 1); PG8_STAGE(PG8_SA(0, 0), a2, voffA);
            PG8_BAR; PG8_WAIT_L(0); PG8_MMA(1, 0, At, B0); PG8_BAR; PG8_SCHED;
            PG8_STAGE(PG8_SB(0, 1), b2 + hstep, voffB);
            PG8_WAIT_V(6); PG8_BAR; PG8_MMA(1, 1, At, B1); PG8_BAR;
            PG8_LDB(B0, 1, 0); PG8_SCHED; PG8_LDA(At, 1, 0); PG8_STAGE(PG8_SA(0, 1), a2 + hstep, voffA);
            PG8_WAIT_L(8); PG8_BAR; PG8_WAIT_L(0); PG8_MMA(0, 0, At, B0); PG8_BAR; PG8_SCHED;
            PG8_LDB(B1, 1, 1); PG8_STAGE(PG8_SB(1, 0), b3, voffB);
            PG8_BAR; PG8_WAIT_L(0); PG8_MMA(0, 1, At, B1); PG8_BAR;
            PG8_LDA(At, 1, 1); PG8_STAGE(PG8_SA(1, 0), a3, voffA);
            PG8_BAR; PG8_WAIT_L(0); PG8_MMA(1, 0, At, B0); PG8_BAR; PG8_SCHED;
            PG8_STAGE(PG8_SB(1, 1), b3 + hstep, voffB);
            PG8_WAIT_V(6); PG8_BAR; PG8_MMA(1, 1, At, B1); PG8_BAR;
            }
        }
        if constexpr (ALIGN_EPI) { if (wr == 0) PG8_BAR; }
        if constexpr (!Epi::AFTER_DRAIN) { E(acc, cur, wr, wc, fr, fq); S.done(cur); }
        if (!has_next) break;
#pragma unroll
        for (int a = 0; a < 2; ++a)
#pragma unroll
            for (int b = 0; b < 2; ++b)
#pragma unroll
                for (int m = 0; m < 4; ++m)
#pragma unroll
                    for (int n = 0; n < 2; ++n) acc[a][b][m][n] = (f32x4){0.f, 0.f, 0.f, 0.f};
        cur = nxt; cA = nA; cB = nB; ++ui;
        if constexpr (ALIGN_EPI) { if (wr == 1) PG8_BAR; }
    }
    PG8_WAIT_V(0);
    if constexpr (!ALIGN_EPI) { if (wr == 0) PG8_BAR; }
    PG8_BAR;
    if constexpr (Epi::AFTER_DRAIN) { E.fused(acc, cur, wr, wc, fr, fq, lds, wid, lane); S.done(cur); }
#undef PG8_SA
#undef PG8_SB
#undef PG8_STAGE
#undef PG8_LDA
#undef PG8_LDB
#undef PG8_MMA
#undef PG8_WAIT_V
#undef PG8_WAIT_L
#undef PG8_BAR
#undef PG8_SCHED
}
}

typedef unsigned short u16;
typedef short bf16x8 __attribute__((ext_vector_type(8)));
typedef short bf16x4 __attribute__((ext_vector_type(4)));
typedef float f32x4 __attribute__((ext_vector_type(4)));
typedef float f32x2 __attribute__((ext_vector_type(2)));
typedef float f32x16 __attribute__((ext_vector_type(16)));
typedef unsigned u32x4 __attribute__((ext_vector_type(4)));
typedef unsigned u32x2 __attribute__((ext_vector_type(2)));

constexpr int SEQ = 8192, NB = 2, T = NB * SEQ, D = 1024, FF = 4096;
constexpr int NIN = 4864;
constexpr int IN_COLS = 4624;
constexpr float ALPHA = 1.41421356237f, LN_EPS = 1e-5f;
constexpr float LAMBDA_INIT = 0.35550906759f;
constexpr float QSCALE = 0.125f * 1.4426950408889634f;
constexpr size_t MiB = 1u << 20;
constexpr size_t WS_WIN = 0;
constexpr size_t WS_WOUT = WS_WIN + (size_t)NIN * D * 2;
constexpr size_t WS_W1 = WS_WOUT + (size_t)D * 2048 * 2;
constexpr size_t WS_W2 = WS_W1 + 2 * (size_t)FF * D * 2;
constexpr size_t WS_WQKV = WS_W2 + 2 * (size_t)FF * D * 2;
constexpr size_t WS_WAO = WS_WQKV + (size_t)3072 * D * 2;
constexpr size_t WS_WEND = WS_WAO + (size_t)D * D * 2;
static_assert(WS_WEND <= 54 * MiB, "weights");
constexpr size_t WS_DT = 54 * MiB;
constexpr size_t WS_ROPE = 55 * MiB;
constexpr size_t WS_CDEC = 56 * MiB;
constexpr size_t WS_LCA = 56 * MiB + 65536;
constexpr size_t WS_LCH = WS_LCA + 524288;
constexpr size_t WS_ZG = 58 * MiB;
constexpr size_t WS_XBC = 122 * MiB;
constexpr size_t WS_XL = 170 * MiB;
constexpr size_t WS_XB = 202 * MiB;
constexpr size_t WS_END = 234 * MiB;
constexpr size_t WS_H = 58 * MiB;
constexpr size_t WS_QK = 58 * MiB;
constexpr size_t WS_VT = 122 * MiB;
constexpr size_t WS_O = 154 * MiB;
constexpr int LDS_BYTES = 147456;

struct Params { const float* in[30]; float* out; unsigned char* ws; };

__device__ __forceinline__ unsigned f2bf(float f) { unsigned u = __builtin_bit_cast(unsigned, f); return (u + 0x7fffu + ((u >> 16) & 1u)) >> 16; }
__device__ __forceinline__ unsigned pk2(float lo, float hi) { return f2bf(lo) | (f2bf(hi) << 16); }
__device__ __forceinline__ float bf2f(unsigned v) { return __builtin_bit_cast(float, v << 16); }
__device__ __forceinline__ float bflo(unsigned w) { return __builtin_bit_cast(float, w << 16); }
__device__ __forceinline__ float bfhi(unsigned w) { return __builtin_bit_cast(float, w & 0xffff0000u); }
__device__ __forceinline__ int crow(int r, int hi) { return (r & 3) + 8 * (r >> 2) + 4 * hi; }
__device__ __forceinline__ f32x16 mfma32(bf16x8 a, bf16x8 b, f32x16 c) { return __builtin_amdgcn_mfma_f32_32x32x16_bf16(a, b, c, 0, 0, 0); }
__device__ __forceinline__ float softplusf(float x) { return x > 20.f ? x : log1pf(expf(x)); }
__device__ __forceinline__ float sigmoidf(float x) { return 1.f / (1.f + expf(-x)); }
__device__ __forceinline__ float fexp(float x) { return __builtin_amdgcn_exp2f(x * 1.4426950408889634f); }
__device__ __forceinline__ int opaque_tid() { int t = threadIdx.x; asm volatile("" : "+v"(t)); return t; }
__device__ __forceinline__ f32x16 zero16() { f32x16 z; for (int i = 0; i < 16; ++i) z[i] = 0.f; return z; }

template <int MODE> struct Epi {
    static constexpr bool PERM = true, AFTER_DRAIN = false;
    u16* o0; u16* o1; u16* o2; float* f0; const float* base; int ldc;
    __device__ __forceinline__ void operator()(const pg8::f32x4 (&acc)[2][2][4][2], const pg8::Unit& u, int wr, int wc, int fr, int fq) const {
#pragma unroll
        for (int ai = 0; ai < 2; ++ai)
#pragma unroll
            for (int m = 0; m < 4; ++m) {
                const int row = u.pm * 256 + ai * 128 + wr * 64 + m * 16 + fr;
#pragma unroll
                for (int bj = 0; bj < 2; ++bj) {
                    const int col0 = u.pn * 256 + bj * 128 + wc * 32 + 8 * fq;
                    f32x4 v0 = acc[ai][bj][m][0], v1 = acc[ai][bj][m][1];
                    if (MODE == 0) {
                        u16* dst;
                        if (u.pn < 8) dst = o0 + (size_t)row * 2048 + col0;
                        else if (u.pn < 14) dst = o1 + (size_t)row * 1536 + (col0 - 2048);
                        else if (u.pn < 18) dst = o2 + (size_t)row * 1024 + (col0 - 3584);
                        else { if (col0 < 4624) { float* d = f0 + (size_t)row * 16 + (col0 - 4608); *(f32x4*)d = v0; *(f32x4*)(d + 4) = v1; } continue; }
                        u32x4 w; w.x = pk2(v0[0], v0[1]); w.y = pk2(v0[2], v0[3]); w.z = pk2(v1[0], v1[1]); w.w = pk2(v1[2], v1[3]);
                        *(u32x4*)dst = w;
                    } else if (MODE == 1) {
                        const float* bs = base + (size_t)row * 1024 + col0; float* o = f0 + (size_t)row * 1024 + col0;
                        const f32x4 b0 = *(const f32x4*)bs, b1 = *(const f32x4*)(bs + 4);
                        *(f32x4*)o = b0 * ALPHA + v0; *(f32x4*)(o + 4) = b1 * ALPHA + v1;
                    } else if (MODE == 2) {
#pragma unroll
                        for (int i = 0; i < 4; ++i) { float a = fmaxf(v0[i], 0.f), b = fmaxf(v1[i], 0.f); v0[i] = a * a; v1[i] = b * b; }
                        u32x4 w; w.x = pk2(v0[0], v0[1]); w.y = pk2(v0[2], v0[3]); w.z = pk2(v1[0], v1[1]); w.w = pk2(v1[2], v1[3]);
                        *(u32x4*)(o0 + (size_t)row * ldc + col0) = w;
                    } else if (MODE == 3) {
                        if ((wc & 1) == 0) {
                            f32x4 p0, p1;
#pragma unroll
                            for (int i = 0; i < 4; ++i) { p0[i] = __shfl_xor(v0[i], 16); p1[i] = __shfl_xor(v1[i], 16); }
                            if (fq < 2) {
                                const float* rp = base + (size_t)row * 16;
                                const f32x4 c0 = *(const f32x4*)rp, c1 = *(const f32x4*)(rp + 4), s0 = *(const f32x4*)(rp + 8), s1 = *(const f32x4*)(rp + 12);
                                if (fq == 0) { v0 = v0 * c0 - p0 * s0; v1 = v1 * c1 - p1 * s1; }
                                else { v0 = v0 * c0 + p0 * s0; v1 = v1 * c1 + p1 * s1; }
                            }
                        }
                        if (col0 < 1024) { v0 = v0 * QSCALE; v1 = v1 * QSCALE; }
                        u32x4 w; w.x = pk2(v0[0], v0[1]); w.y = pk2(v0[2], v0[3]); w.z = pk2(v1[0], v1[1]); w.w = pk2(v1[2], v1[3]);
                        *(u32x4*)(o0 + (size_t)row * 2048 + col0) = w;
                    } else {
                        u32x4 w; w.x = pk2(v0[0], v0[1]); w.y = pk2(v0[2], v0[3]); w.z = pk2(v1[0], v1[1]); w.w = pk2(v1[2], v1[3]);
                        *(u32x4*)(o0 + (size_t)row * ldc + col0) = w;
                    }
                }
            }
    }
};

template <int MODE> __device__ __forceinline__ void run_gemm(unsigned char* lds, const u16* A, const u16* Bt, int M, int N, int K, const Epi<MODE>& E) {
    pg8::Gemm g{A, Bt, M, N, K}; pg8::StaticOrder S; S.init(M, N, (int)gridDim.x, (int)blockIdx.x);
    pg8::gemm_phase<Epi<MODE>, pg8::StaticOrder, true, true>((PG8_LAS unsigned char*)lds, g, S, E);
    __syncthreads();
}

__device__ __forceinline__ int win_src_col(int n) {
    if (n < 1024) return n;
    if (n < 2048) return n - 1024 + 2576;
    if (n < 3584) return n - 2048 + 1024;
    if (n < 4608) return n - 3584 + 3600;
    if (n < 4624) return n - 4608 + 2560;
    return -1;
}
template <bool MAP> __device__ __forceinline__ void transpose_item(const float* W, int K, int Nsrc, int nblk, u16* WT, float* scr, int item, int lane) {
    const int kb = item / nblk, nb = item % nblk, k0 = 64 * kb, n0 = 32 * nb;
    const int nn = n0 + (lane & 31); const int sc = MAP ? win_src_col(nn) : nn;
#pragma unroll 8
    for (int i = 0; i < 32; ++i) { const int kk = 2 * i + (lane >> 5); scr[kk * 33 + (lane & 31)] = sc >= 0 ? W[(size_t)(k0 + kk) * Nsrc + sc] : 0.f; }
    __builtin_amdgcn_s_waitcnt(0xc07f); asm volatile("" ::: "memory");
    const int c = lane & 7;
#pragma unroll
    for (int j = 0; j < 4; ++j) { const int n = (lane >> 3) + 8 * j; const float* s = scr + (8 * c) * 33 + n;
        u32x4 o; o.x = pk2(s[0 * 33], s[1 * 33]); o.y = pk2(s[2 * 33], s[3 * 33]); o.z = pk2(s[4 * 33], s[5 * 33]); o.w = pk2(s[6 * 33], s[7 * 33]);
        *(u32x4*)(WT + (size_t)(n0 + n) * K + k0 + 8 * c) = o; }
    __builtin_amdgcn_s_waitcnt(0xc07f); asm volatile("" ::: "memory");
}
__device__ __forceinline__ float wave_sum(float v) {
#pragma unroll
    for (int o = 1; o < 64; o <<= 1) v += __shfl_xor(v, o);
    return v;
}
__device__ __forceinline__ void ln_phase(const float* v, const float* g, const float* bt, float* outf, u16* outb) {
    const int tid = opaque_tid(), lane = tid & 63, wave = tid >> 6;
    const int gw = blockIdx.x * 8 + wave, NGW = gridDim.x * 8;
    f32x4 gg[4], bb[4];
#pragma unroll
    for (int j = 0; j < 4; ++j) { gg[j] = *((const f32x4*)g + lane + 64 * j); bb[j] = *((const f32x4*)bt + lane + 64 * j); }
    for (int m = gw; m < T; m += NGW) {
        const f32x4* xr = (const f32x4*)(v + (size_t)m * D) + lane;
        f32x4 x[4]; float s = 0.f;
#pragma unroll
        for (int j = 0; j < 4; ++j) { x[j] = xr[64 * j]; s += (x[j].x + x[j].y) + (x[j].z + x[j].w); }
        const float mean = wave_sum(s) * (1.f / D); float s2 = 0.f;
#pragma unroll
        for (int j = 0; j < 4; ++j) { x[j] = x[j] - mean; s2 += (x[j].x * x[j].x + x[j].y * x[j].y) + (x[j].z * x[j].z + x[j].w * x[j].w); }
        const float rstd = 1.f / sqrtf(wave_sum(s2) * (1.f / D) + LN_EPS);
#pragma unroll
        for (int j = 0; j < 4; ++j) x[j] = x[j] * rstd * gg[j] + bb[j];
        if (outf) { f32x4* o = (f32x4*)(outf + (size_t)m * D) + lane;
#pragma unroll
            for (int j = 0; j < 4; ++j) o[64 * j] = x[j]; }
        if (outb) { u32x2* o = (u32x2*)(outb + (size_t)m * D) + lane;
#pragma unroll
            for (int j = 0; j < 4; ++j) { u32x2 w; w.x = pk2(x[j].x, x[j].y); w.y = pk2(x[j].z, x[j].w); o[64 * j] = w; } }
    }
}

__device__ __forceinline__ void prologue(const Params& P, unsigned char* lds) {
    const int tid = opaque_tid(), lane = tid & 63, wave = tid >> 6;
    float* scr = (float*)(lds + wave * 16384);
    const int gw = blockIdx.x * 8 + wave, NGW = gridDim.x * 8;
    unsigned char* ws = P.ws;
    constexpr int I_IN = (D / 64) * (NIN / 32), I_OUT = (2048 / 64) * (D / 32), I_1 = (D / 64) * (FF / 32), I_2 = (FF / 64) * (D / 32), I_QKV = (D / 64) * (3072 / 32), I_AO = (D / 64) * (D / 32);
    constexpr int NITEMS = I_IN + I_OUT + 2 * I_1 + 2 * I_2 + I_QKV + I_AO;
    for (int it = gw; it < NITEMS; it += NGW) {
        int r = it;
        if (r < I_IN) { transpose_item<true>(P.in[2], D, IN_COLS, NIN / 32, (u16*)(ws + WS_WIN), scr, r, lane); continue; } r -= I_IN;
        if (r < I_OUT) { transpose_item<false>(P.in[16], 2048, D, D / 32, (u16*)(ws + WS_WOUT), scr, r, lane); continue; } r -= I_OUT;
        if (r < I_1) { transpose_item<false>(P.in[26], D, FF, FF / 32, (u16*)(ws + WS_W1), scr, r, lane); continue; } r -= I_1;
        if (r < I_1) { transpose_item<false>(P.in[26] + (size_t)D * FF, D, FF, FF / 32, (u16*)(ws + WS_W1) + (size_t)FF * D, scr, r, lane); continue; } r -= I_1;
        if (r < I_2) { transpose_item<false>(P.in[27], FF, D, D / 32, (u16*)(ws + WS_W2), scr, r, lane); continue; } r -= I_2;
        if (r < I_2) { transpose_item<false>(P.in[27] + (size_t)D * FF, FF, D, D / 32, (u16*)(ws + WS_W2) + (size_t)FF * D, scr, r, lane); continue; } r -= I_2;
        if (r < I_QKV) { transpose_item<false>(P.in[17], D, 3072, 3072 / 32, (u16*)(ws + WS_WQKV), scr, r, lane); continue; } r -= I_QKV;
        transpose_item<false>(P.in[23], D, D, D / 32, (u16*)(ws + WS_WAO), scr, r, lane);
    }
    for (int m = gw; m < T; m += NGW) {
        const f32x4* xr = (const f32x4*)(P.in[0] + (size_t)m * D) + lane; u32x2* o = (u32x2*)((u16*)(ws + WS_XB) + (size_t)m * D) + lane;
#pragma unroll
        for (int j = 0; j < 4; ++j) { const f32x4 x = xr[64 * j]; u32x2 w; w.x = pk2(x.x, x.y); w.y = pk2(x.z, x.w); o[64 * j] = w; }
    }
    const int* pos = (const int*)P.in[1]; float* rope = (float*)(ws + WS_ROPE);
    for (int e = blockIdx.x * 512 + tid; e < T * 8; e += gridDim.x * 512) {
        const int tok = e >> 3, i = e & 7;
        const float inv = powf(500000.0f, -(float)i * 0.125f);
        const float ang = (float)pos[tok] * inv;
        rope[tok * 16 + i] = cosf(ang); rope[tok * 16 + 8 + i] = sinf(ang);
    }
}

template <int NCH, int ROWS, bool SILU, bool TRANS>
__device__ __forceinline__ void conv_tile(const u16* src, int ld, int col0, const float* cw, const float* cb, int cld, size_t tokbase, int t0,
                                          unsigned char* dst, int RS, const float* rowscale, int tid) {
    static_assert(NCH * (128 / ROWS) == 512, "all 512 threads work");
    const int ch = tid % NCH, rg = tid / NCH, c0 = col0 + ch * 8;
    u32x4 in[ROWS + 3];
#pragma unroll
    for (int i = 0; i < ROWS + 3; ++i) { const int tr = t0 + rg * ROWS - 3 + i;
        if (tr >= 0) in[i] = *(const u32x4*)(src + (tokbase + tr) * ld + c0); else in[i] = (u32x4){0u, 0u, 0u, 0u}; }
    float out[ROWS][8];
#pragma unroll
    for (int hf = 0; hf < 2; ++hf) {
        f32x4 w[4];
#pragma unroll
        for (int k = 0; k < 4; ++k) w[k] = *(const f32x4*)(cw + (size_t)k * cld + c0 + 4 * hf);
        const f32x4 bias = *(const f32x4*)(cb + c0 + 4 * hf);
#pragma unroll
        for (int j = 0; j < ROWS; ++j) {
            const float rs = rowscale ? rowscale[rg * ROWS + j] : 1.f;
#pragma unroll
            for (int e = 0; e < 4; ++e) {
                float a = bias[e];
#pragma unroll
                for (int k = 0; k < 4; ++k) { const unsigned wd = in[j + k][2 * hf + (e >> 1)]; const float xv = (e & 1) ? bfhi(wd) : bflo(wd); a += w[k][e] * xv; }
                if (SILU) a = a / (1.f + expf(-a));
                out[j][4 * hf + e] = a * rs;
            }
        }
    }
    if (TRANS) {
#pragma unroll
        for (int e = 0; e < 8; ++e) {
            if (ROWS == 4) { u32x2 wv; wv.x = pk2(out[0][e], out[1][e]); wv.y = pk2(out[ROWS - 2][e], out[ROWS - 1][e]); *(u32x2*)(dst + (size_t)(ch * 8 + e) * RS + rg * 8) = wv; }
            else { *(unsigned*)(dst + (size_t)(ch * 8 + e) * RS + rg * 4) = pk2(out[0][e], out[1][e]); }
        }
    } else {
#pragma unroll
        for (int j = 0; j < ROWS; ++j) { u32x4 wv; wv.x = pk2(out[j][0], out[j][1]); wv.y = pk2(out[j][2], out[j][3]); wv.z = pk2(out[j][4], out[j][5]); wv.w = pk2(out[j][6], out[j][7]);
            *(u32x4*)(dst + (size_t)(rg * ROWS + j) * RS + ch * 16) = wv; }
    }
}

constexpr int R272 = 272;
__device__ __forceinline__ void ssd_dt_acum(const Params& P, float* s_dt, float* s_ac, int tok0, int g, int tid) {
    const float* dtraw = (const float*)(P.ws + WS_DT);
#pragma unroll
    for (int i = 0; i < 2; ++i) { const int idx = tid + 512 * i, hh = idx >> 7, l = idx & 127, hd = g * 8 + hh;
        s_dt[idx] = softplusf(dtraw[(size_t)(tok0 + l) * 16 + hd] + P.in[5][hd]); }
    __syncthreads();
#pragma unroll
    for (int i = 0; i < 2; ++i) { const int idx = tid + 512 * i, hh = idx >> 7, l = idx & 127, hd = g * 8 + hh;
        const float a = -expf(P.in[6][hd]); float s = 0.f;
        for (int q = 0; q <= l; ++q) s += s_dt[hh * 128 + q] * a;
        s_ac[idx] = s; }
    __syncthreads();
}

__device__ __forceinline__ void ssd_A_unit(const Params& P, unsigned char* lds, int b, int c, int g) {
    const int tid = opaque_tid(), lane = tid & 63, r32 = lane & 31, hi = lane >> 5, w = tid >> 6;
    unsigned char* BT = lds; unsigned char* XsT = lds + 34816;
    float* s_dt = (float*)(lds + 52224); float* s_ac = (float*)(lds + 56320); float* s_rs = (float*)(lds + 60416);
    const int tok0 = b * SEQ + c * 128;
    const u16* XBC = (const u16*)(P.ws + WS_XBC);
    ssd_dt_acum(P, s_dt, s_ac, tok0, g, tid);
    conv_tile<16, 4, true, true>(XBC, 1536, 1024 + g * 128, P.in[3], P.in[4], 1536, (size_t)b * SEQ, c * 128, BT, R272, nullptr, tid);
    for (int hh = 0; hh < 8; ++hh) {
        const int hd = g * 8 + hh;
        __syncthreads();
        if (tid < 128) s_rs[tid] = s_dt[hh * 128 + tid] * expf(s_ac[hh * 128 + 127] - s_ac[hh * 128 + tid]);
        __syncthreads();
        conv_tile<8, 2, true, true>(XBC, 1536, hd * 64, P.in[3], P.in[4], 1536, (size_t)b * SEQ, c * 128, XsT, R272, s_rs, tid);
        __syncthreads();
        const int mi = w >> 2, ni = w & 3;
        f32x16 acc = zero16();
#pragma unroll
        for (int k0 = 0; k0 < 8; ++k0) {
            const bf16x8 a = *(const bf16x8*)(XsT + (32 * mi + r32) * R272 + (16 * k0 + 8 * hi) * 2);
            const bf16x8 bb = *(const bf16x8*)(BT + (32 * ni + r32) * R272 + (16 * k0 + 8 * hi) * 2);
            acc = mfma32(a, bb, acc);
        }
        float* sp = P.out + ((size_t)(b * 64 + c) * 16 + hd) * 8192;
#pragma unroll
        for (int r = 0; r < 16; ++r) sp[(32 * mi + crow(r, hi)) * 128 + 32 * ni + r32] = acc[r];
        if (tid == 0) ((float*)(P.ws + WS_CDEC))[(b * 64 + c) * 16 + hd] = expf(s_ac[hh * 128 + 127]);
    }
    __syncthreads();
}

__device__ __forceinline__ void ssd_C_unit(const Params& P, unsigned char* lds, int b, int c, int g) {
    const int tid = opaque_tid(), lane = tid & 63, r32 = lane & 31, hi = lane >> 5, w = tid >> 6;
    unsigned char* Cs = lds; unsigned char* Ms = lds + 34816; unsigned char* Ps = lds + 69632; unsigned char* Xt = lds + 87040;
    float* s_dt = (float*)(lds + 104448); float* s_ac = (float*)(lds + 108544); float* s_ssq = (float*)(lds + 112640);
    const int tok0 = b * SEQ + c * 128;
    const u16* XBC = (const u16*)(P.ws + WS_XBC); u16* ZG = (u16*)(P.ws + WS_ZG);
    if (tid < 128) s_ssq[tid] = 0.f;
    ssd_dt_acum(P, s_dt, s_ac, tok0, g, tid);
    conv_tile<16, 4, true, false>(XBC, 1536, 1280 + g * 128, P.in[3], P.in[4], 1536, (size_t)b * SEQ, c * 128, Cs, R272, nullptr, tid);
    conv_tile<16, 4, true, false>(XBC, 1536, 1024 + g * 128, P.in[3], P.in[4], 1536, (size_t)b * SEQ, c * 128, Ms, R272, nullptr, tid);
    __syncthreads();
    const int mi = w >> 1, nib = (w & 1) * 2;
    f32x16 cb[2];
#pragma unroll
    for (int t2 = 0; t2 < 2; ++t2) { const int ni = nib + t2; cb[t2] = zero16();
        if (ni <= mi) {
#pragma unroll
            for (int k0 = 0; k0 < 8; ++k0) {
                const bf16x8 a = *(const bf16x8*)(Cs + (32 * mi + r32) * R272 + (16 * k0 + 8 * hi) * 2);
                const bf16x8 bb = *(const bf16x8*)(Ms + (32 * ni + r32) * R272 + (16 * k0 + 8 * hi) * 2);
                cb[t2] = mfma32(a, bb, cb[t2]);
            } } }
    __syncthreads();
    unsigned cbp[2][8];
#pragma unroll
    for (int t2 = 0; t2 < 2; ++t2)
#pragma unroll
        for (int r = 0; r < 8; ++r) cbp[t2][r] = pk2(cb[t2][2 * r], cb[t2][2 * r + 1]);
    const int pt = w & 1;
#pragma unroll 1
    for (int hh = 0; hh < 8; ++hh) {
        const int hd = g * 8 + hh;
#pragma unroll
        for (int t2 = 0; t2 < 2; ++t2) { const int ni = nib + t2; const int s = 32 * ni + r32; const float acs = s_ac[hh * 128 + s], dts = s_dt[hh * 128 + s];
#pragma unroll
            for (int r = 0; r < 16; ++r) { const int l = 32 * mi + crow(r, hi);
                const float cbv = (r & 1) ? bfhi(cbp[t2][r >> 1]) : bflo(cbp[t2][r >> 1]);
                float v = 0.f; if (s <= l) v = cbv * fexp(s_ac[hh * 128 + l] - acs) * dts;
                *(u16*)(Ms + l * R272 + s * 2) = (u16)f2bf(v); } }
        conv_tile<8, 2, true, true>(XBC, 1536, hd * 64, P.in[3], P.in[4], 1536, (size_t)b * SEQ, c * 128, Xt, R272, nullptr, tid);
        { const float* sp = P.out + ((size_t)(b * 64 + c) * 16 + hd) * 8192;
#pragma unroll
            for (int i = 0; i < 4; ++i) { const int idx4 = tid + 512 * i, p = idx4 >> 5, n4 = (idx4 & 31) * 4; const f32x4 v = *(const f32x4*)(sp + p * 128 + n4);
                u32x2 wv; wv.x = pk2(v.x, v.y); wv.y = pk2(v.z, v.w); *(u32x2*)(Ps + p * R272 + n4 * 2) = wv; } }
        __syncthreads();
        f32x16 acc = zero16();
#pragma unroll
        for (int k0 = 0; k0 < 8; ++k0) {
            const bf16x8 a = *(const bf16x8*)(Cs + (32 * mi + r32) * R272 + (16 * k0 + 8 * hi) * 2);
            const bf16x8 bb = *(const bf16x8*)(Ps + (32 * pt + r32) * R272 + (16 * k0 + 8 * hi) * 2);
            acc = mfma32(a, bb, acc);
        }
#pragma unroll
        for (int r = 0; r < 16; ++r) acc[r] *= fexp(s_ac[hh * 128 + 32 * mi + crow(r, hi)]);
#pragma unroll
        for (int k0 = 0; k0 < 8; ++k0) {
            if (16 * k0 <= 32 * mi + 31) {
                const bf16x8 a = *(const bf16x8*)(Ms + (32 * mi + r32) * R272 + (16 * k0 + 8 * hi) * 2);
                const bf16x8 bb = *(const bf16x8*)(Xt + (32 * pt + r32) * R272 + (16 * k0 + 8 * hi) * 2);
                acc = mfma32(a, bb, acc);
            } }
        const float dsk = P.in[7][hd]; const int p = 32 * pt + r32;
#pragma unroll
        for (int r = 0; r < 16; ++r) { const int l = 32 * mi + crow(r, hi);
            const float xv = bf2f(*(const u16*)(Xt + p * R272 + l * 2));
            const float y = acc[r] + dsk * xv;
            u16* zp = ZG + (size_t)(tok0 + l) * 2048 + hd * 64 + p;
            const float z = bf2f(*zp);
            const unsigned ygb = f2bf(y * z / (1.f + fexp(-z)));
            *zp = (u16)ygb;
            const float ygf = bf2f(ygb);
            float sq = ygf * ygf;
            sq += __shfl_xor(sq, 1); sq += __shfl_xor(sq, 2); sq += __shfl_xor(sq, 4); sq += __shfl_xor(sq, 8); sq += __shfl_xor(sq, 16);
            if (r32 == 0) atomicAdd(&s_ssq[l], sq); }
        __syncthreads();
    }
    float rs[16];
#pragma unroll
    for (int r = 0; r < 16; ++r) rs[r] = 1.f / sqrtf(s_ssq[32 * mi + crow(r, hi)] * (1.f / 512.f) + LN_EPS);
#pragma unroll 1
    for (int hh = 0; hh < 8; ++hh) { const int hd = g * 8 + hh, p = 32 * pt + r32; const float nw = P.in[8][hd * 64 + p];
#pragma unroll
        for (int r = 0; r < 16; ++r) { const int l = 32 * mi + crow(r, hi); u16* zp = ZG + (size_t)(tok0 + l) * 2048 + hd * 64 + p;
            const float yv = bf2f(*(volatile u16*)zp);
            *zp = (u16)f2bf(yv * rs[r] * nw); } }
    __syncthreads();
}

template <bool PHASE_C>
__device__ __forceinline__ void lru_unit(const Params& P, unsigned char* lds, int b, int c, int h) {
    const int tid = opaque_tid(), lane = tid & 63, r32 = lane & 31, hi = lane >> 5, w = tid >> 6;
    unsigned char* Xs = lds; unsigned char* WaT = lds + 18432; unsigned char* WxT = lds + 27648;
    float* af = (float*)(lds + 36864); float* uf = (float*)(lds + 69632); float* segA = (float*)(lds + 102400); float* segH = (float*)(lds + 104448);
    const int tok0 = b * SEQ + c * 128;
    const u16* XL = (const u16*)(P.ws + WS_XL); u16* ZG = (u16*)(P.ws + WS_ZG);
    conv_tile<8, 2, false, false>(XL, 1024, h * 64, P.in[9], P.in[10], 1024, (size_t)b * SEQ, c * 128, Xs, 144, nullptr, tid);
    { const int i = tid >> 3, j0 = (tid & 7) * 8;
        const float* wa = P.in[11] + (size_t)h * 4096 + i * 64 + j0; const float* wx = P.in[13] + (size_t)h * 4096 + i * 64 + j0;
#pragma unroll
        for (int e4 = 0; e4 < 2; ++e4) { const f32x4 va = *(const f32x4*)(wa + 4 * e4), vx = *(const f32x4*)(wx + 4 * e4);
#pragma unroll
            for (int e = 0; e < 4; ++e) { *(u16*)(WaT + (j0 + 4 * e4 + e) * 144 + i * 2) = (u16)f2bf(va[e]); *(u16*)(WxT + (j0 + 4 * e4 + e) * 144 + i * 2) = (u16)f2bf(vx[e]); } } }
    __syncthreads();
    {
        const int mi = w >> 1, ni = w & 1;
        f32x16 accA = zero16(), accX = zero16();
#pragma unroll
        for (int k0 = 0; k0 < 4; ++k0) {
            const bf16x8 a = *(const bf16x8*)(Xs + (32 * mi + r32) * 144 + (16 * k0 + 8 * hi) * 2);
            const bf16x8 ba = *(const bf16x8*)(WaT + (32 * ni + r32) * 144 + (16 * k0 + 8 * hi) * 2);
            const bf16x8 bx = *(const bf16x8*)(WxT + (32 * ni + r32) * 144 + (16 * k0 + 8 * hi) * 2);
            accA = mfma32(a, ba, accA); accX = mfma32(a, bx, accX);
        }
        const int j = 32 * ni + r32, chn = h * 64 + j;
        const float ba_ = P.in[12][chn], bx_ = P.in[14][chn], sp = softplusf(-P.in[15][chn]);
#pragma unroll
        for (int r = 0; r < 16; ++r) { const int l = 32 * mi + crow(r, hi);
            const float rg = sigmoidf(accA[r] + ba_), ig = sigmoidf(accX[r] + bx_);
            const float la = -8.0f * rg * sp; const float a = expf(la); const float mult = sqrtf(fmaxf(-expm1f(2.f * la), 0.f));
            const float xl = bf2f(*(const u16*)(Xs + l * 144 + j * 2));
            af[l * 64 + j] = a; uf[l * 64 + j] = mult * (ig * xl); }
    }
    __syncthreads();
    const int j = tid & 63, seg = tid >> 6, chn = h * 64 + j;
    float Pp = 1.f, hl = 0.f;
#pragma unroll
    for (int i = 0; i < 16; ++i) { const int l = seg * 16 + i; const float a = af[l * 64 + j]; hl = a * hl + uf[l * 64 + j]; Pp *= a;
        if (PHASE_C) { uf[l * 64 + j] = hl; af[l * 64 + j] = Pp; } }
    segA[seg * 64 + j] = Pp; segH[seg * 64 + j] = hl;
    __syncthreads();
    float cin = PHASE_C ? ((const float*)(P.ws + WS_LCH))[(size_t)(b * 64 + c) * 1024 + chn] : 0.f;
    float At = 1.f;
    for (int s = 0; s < seg; ++s) { const float a = segA[s * 64 + j]; cin = a * cin + segH[s * 64 + j]; At *= a; }
    if (!PHASE_C) {
        if (seg == 7) { ((float*)(P.ws + WS_LCA))[(size_t)(b * 64 + c) * 1024 + chn] = At * Pp; ((float*)(P.ws + WS_LCH))[(size_t)(b * 64 + c) * 1024 + chn] = Pp * cin + hl; }
    } else {
#pragma unroll
        for (int i = 0; i < 16; ++i) { const int l = seg * 16 + i; const float hv = uf[l * 64 + j] + af[l * 64 + j] * cin;
            u16* gp = ZG + (size_t)(tok0 + l) * 2048 + 1024 + chn; const float gt = bf2f(*gp);
            const float u_ = 0.7978845608028654f * (gt + 0.044715f * gt * gt * gt); const float th = 1.f - 2.f / (1.f + expf(2.f * u_));
            *gp = (u16)f2bf(hv * 0.5f * gt * (1.f + th)); }
    }
    __syncthreads();
}

__device__ __forceinline__ void scan_phase(const Params& P) {
    const int gtid = blockIdx.x * 512 + opaque_tid(), NT_ = gridDim.x * 512;
    float* st = P.out; const float* cdec = (const float*)(P.ws + WS_CDEC);
    for (int e2 = gtid; e2 < 2 * 16 * 4096; e2 += NT_) {
        const int bh = e2 >> 12, b = bh >> 4, h = bh & 15, off = (e2 & 4095) * 2;
        f32x2 prev = (f32x2){0.f, 0.f};
        for (int c0 = 0; c0 < 64; c0 += 8) {
            f32x2 tmp[8]; float dec[8];
#pragma unroll
            for (int q = 0; q < 8; ++q) { tmp[q] = *(const f32x2*)(st + ((size_t)(b * 64 + c0 + q) * 16 + h) * 8192 + off); dec[q] = cdec[(b * 64 + c0 + q) * 16 + h]; }
#pragma unroll
            for (int q = 0; q < 8; ++q) { *(f32x2*)(st + ((size_t)(b * 64 + c0 + q) * 16 + h) * 8192 + off) = prev; prev = prev * dec[q] + tmp[q]; }
        }
    }
    if (gtid < 2048) {
        const int b = gtid >> 10, chn = gtid & 1023; float hin = 0.f;
        const float* cA = (const float*)(P.ws + WS_LCA); float* cH = (float*)(P.ws + WS_LCH);
        for (int c0 = 0; c0 < 64; c0 += 8) {
            float A_[8], H_[8];
#pragma unroll
            for (int q = 0; q < 8; ++q) { A_[q] = cA[(size_t)(b * 64 + c0 + q) * 1024 + chn]; H_[q] = cH[(size_t)(b * 64 + c0 + q) * 1024 + chn]; }
#pragma unroll
            for (int q = 0; q < 8; ++q) { cH[(size_t)(b * 64 + c0 + q) * 1024 + chn] = hin; hin = A_[q] * hin + H_[q]; }
        }
    }
}

namespace att {
constexpr int KROW = 272, VROW = 136, KBYTES = 64 * KROW, VBYTES = 128 * VROW, BUF = KBYTES + VBYTES;
__device__ __forceinline__ void attn_unit(unsigned char* lds, const u16* QK, const u16* Vt, u16* O, const float* subln, float lam, int b, int h, int qb) {
    const int tid = opaque_tid(), lane = tid & 63, r32 = lane & 31, hi = lane >> 5, w = tid >> 6, qg = w >> 1, c = w & 1;
    const int q0 = qb * 128, qw = q0 + 32 * qg;
    const size_t rowbase = (size_t)b * SEQ;
    bf16x8 qf[4];
    { const u16* qp = QK + (rowbase + qw + r32) * 2048 + h * 128 + c * 64 + 8 * hi;
#pragma unroll
      for (int d0 = 0; d0 < 4; ++d0) qf[d0] = *(const bf16x8*)(qp + d0 * 16); }
    f32x16 o[4];
#pragma unroll
    for (int dt = 0; dt < 4; ++dt) o[dt] = zero16();
    float mrun = -1e30f, lrun = 0.f;
    const int NT = 2 * (qb + 1);
    const int krow = tid >> 4, kch = tid & 15, vrow = tid >> 3, vch = tid & 7;
    const u16* kg = QK + (rowbase + krow) * 2048 + 1024 + h * 128 + kch * 8;
    const u16* vg = Vt + (size_t)(h * 128 + vrow) * T + rowbase + vch * 8;
    u32x4 kr[2], vr[2];
#define ATT_LOAD(t) do { kr[0] = *(const u32x4*)(kg + (size_t)(t) * 64 * 2048); kr[1] = *(const u32x4*)(kg + (size_t)(t) * 64 * 2048 + 32 * 2048); \
                         vr[0] = *(const u32x4*)(vg + (size_t)(t) * 64); vr[1] = *(const u32x4*)(vg + (size_t)(t) * 64 + (size_t)64 * T); } while (0)
#define ATT_STORE(bufp) do { unsigned char* kb_ = (bufp); unsigned char* vb_ = kb_ + KBYTES; \
        *(u32x4*)(kb_ + krow * KROW + kch * 16) = kr[0]; *(u32x4*)(kb_ + (krow + 32) * KROW + kch * 16) = kr[1]; \
        *(u32x2*)(vb_ + vrow * VROW + vch * 16) = (u32x2){vr[0].x, vr[0].y}; *(u32x2*)(vb_ + vrow * VROW + vch * 16 + 8) = (u32x2){vr[0].z, vr[0].w}; \
        *(u32x2*)(vb_ + (vrow + 64) * VROW + vch * 16) = (u32x2){vr[1].x, vr[1].y}; *(u32x2*)(vb_ + (vrow + 64) * VROW + vch * 16 + 8) = (u32x2){vr[1].z, vr[1].w}; } while (0)
    ATT_LOAD(0); ATT_STORE(lds); __syncthreads();
    for (int t = 0; t < NT; ++t) {
        const unsigned char* kb = lds + (t & 1) * BUF; const unsigned char* vb = kb + KBYTES;
        if (t + 1 < NT) ATT_LOAD(t + 1);
        if (64 * t <= qw + 31) {
            bf16x8 pb[4];
            {
                f32x16 p0 = zero16(), p1 = zero16();
#pragma unroll
                for (int d0 = 0; d0 < 4; ++d0) {
                    const bf16x8 k0f = *(const bf16x8*)(kb + r32 * KROW + (c * 64 + d0 * 16 + 8 * hi) * 2);
                    const bf16x8 k1f = *(const bf16x8*)(kb + (32 + r32) * KROW + (c * 64 + d0 * 16 + 8 * hi) * 2);
                    p0 = mfma32(k0f, qf[d0], p0); p1 = mfma32(k1f, qf[d0], p1);
                }
                if (64 * t + 63 > qw) {
                    const int qgl = qw + r32;
#pragma unroll
                    for (int r = 0; r < 16; ++r) { const int kv = 64 * t + crow(r, hi); if (kv > qgl) p0[r] = -INFINITY; if (kv + 32 > qgl) p1[r] = -INFINITY; }
                }
                float mx = fmaxf(p0[0], p1[0]);
#pragma unroll
                for (int r = 1; r < 16; ++r) mx = fmaxf(mx, fmaxf(p0[r], p1[r]));
                mx = fmaxf(mx, __shfl_xor(mx, 32));
                const float mn = fmaxf(mrun, mx); const float f = __builtin_amdgcn_exp2f(mrun - mn); mrun = mn;
                float sum = 0.f;
#pragma unroll
                for (int r = 0; r < 16; ++r) { p0[r] = __builtin_amdgcn_exp2f(p0[r] - mn); p1[r] = __builtin_amdgcn_exp2f(p1[r] - mn); sum += p0[r] + p1[r]; }
                lrun = lrun * f + sum;
#pragma unroll
                for (int dt = 0; dt < 4; ++dt)
#pragma unroll
                    for (int r = 0; r < 16; ++r) o[dt][r] *= f;
#pragma unroll
                for (int s = 0; s < 2; ++s) {
                    u32x4 a, bq;
                    a.x = pk2(p0[8 * s + 0], p0[8 * s + 1]); a.y = pk2(p0[8 * s + 2], p0[8 * s + 3]); a.z = pk2(p0[8 * s + 4], p0[8 * s + 5]); a.w = pk2(p0[8 * s + 6], p0[8 * s + 7]);
                    bq.x = pk2(p1[8 * s + 0], p1[8 * s + 1]); bq.y = pk2(p1[8 * s + 2], p1[8 * s + 3]); bq.z = pk2(p1[8 * s + 4], p1[8 * s + 5]); bq.w = pk2(p1[8 * s + 6], p1[8 * s + 7]);
                    pb[s] = __builtin_bit_cast(bf16x8, a); pb[2 + s] = __builtin_bit_cast(bf16x8, bq);
                }
            }
#pragma unroll
            for (int dt = 0; dt < 4; ++dt)
#pragma unroll
                for (int s = 0; s < 4; ++s) {
                    const unsigned char* ap = vb + (32 * dt + r32) * VROW + (16 * s + 4 * hi) * 2;
                    const u32x2 lo = *(const u32x2*)ap, hi2 = *(const u32x2*)(ap + 16);
                    const bf16x8 vf = __builtin_bit_cast(bf16x8, (u32x4){lo.x, lo.y, hi2.x, hi2.y});
                    o[dt] = mfma32(vf, pb[s], o[dt]);
                }
        }
        if (t + 1 < NT) ATT_STORE(lds + ((t + 1) & 1) * BUF);
        __syncthreads();
    }
#undef ATT_LOAD
#undef ATT_STORE
    const float lt = lrun + __shfl_xor(lrun, 32);
    float* xb = (float*)lds + qg * 4096;
    if (c == 1) { const float inv = lam / lt;
#pragma unroll
        for (int dt = 0; dt < 4; ++dt)
#pragma unroll
            for (int r = 0; r < 16; ++r) xb[(32 * dt + crow(r, hi)) * 32 + r32] = o[dt][r] * inv; }
    __syncthreads();
    if (c == 0) {
        const float inv = 1.f / lt; float ssq = 0.f;
#pragma unroll
        for (int dt = 0; dt < 4; ++dt)
#pragma unroll
            for (int r = 0; r < 16; ++r) { const float v = o[dt][r] * inv - xb[(32 * dt + crow(r, hi)) * 32 + r32]; o[dt][r] = v; ssq += v * v; }
        ssq += __shfl_xor(ssq, 32);
        const float rstd = (1.f - LAMBDA_INIT) / sqrtf(ssq * (1.f / 128.f) + LN_EPS);
        u16* op = O + (rowbase + qw + r32) * 1024 + h * 128;
#pragma unroll
        for (int dt = 0; dt < 4; ++dt)
#pragma unroll
            for (int g4 = 0; g4 < 4; ++g4) { const int d = 32 * dt + 8 * g4 + 4 * hi; const f32x4 sw = *(const f32x4*)(subln + d);
                u32x2 wv; wv.x = pk2(o[dt][4 * g4 + 0] * rstd * sw.x, o[dt][4 * g4 + 1] * rstd * sw.y); wv.y = pk2(o[dt][4 * g4 + 2] * rstd * sw.z, o[dt][4 * g4 + 3] * rstd * sw.w);
                *(u32x2*)(op + d) = wv; }
    }
    __syncthreads();
}
}

__device__ __forceinline__ void attn_phase(const Params& P, unsigned char* lds) {
    float s1 = 0.f, s2 = 0.f;
    for (int i = 0; i < 64; ++i) { s1 += P.in[18][i] * P.in[19][i]; s2 += P.in[20][i] * P.in[21][i]; }
    const float lam = expf(s1) - expf(s2) + LAMBDA_INIT;
    const u16* QK = (const u16*)(P.ws + WS_QK); const u16* Vt = (const u16*)(P.ws + WS_VT); u16* O = (u16*)(P.ws + WS_O);
    for (int p = blockIdx.x; p < 512; p += gridDim.x) {
        const int bh = p >> 5, s = p & 31, b = bh >> 3, h = bh & 7;
        att::attn_unit(lds, QK, Vt, O, P.in[22], lam, b, h, 63 - s);
        att::attn_unit(lds, QK, Vt, O, P.in[22], lam, b, h, s);
    }
}

__global__ void __launch_bounds__(512) hybrid_fwd(Params P) {
    extern __shared__ __attribute__((aligned(16))) unsigned char lds[];
    cg::grid_group grid = cg::this_grid();
    unsigned char* ws = P.ws;
    const int G = gridDim.x, bx = blockIdx.x;
    u16* XB = (u16*)(ws + WS_XB); u16* ZG = (u16*)(ws + WS_ZG); u16* HB = (u16*)(ws + WS_H);

#ifndef PHM
#define PHM 0xffff
#endif
#define PH(n) if (PHM & (1 << (n)))
    PH(0) prologue(P, lds);
    grid.sync();
    PH(1) { Epi<0> E{ZG, (u16*)(ws + WS_XBC), (u16*)(ws + WS_XL), (float*)(ws + WS_DT), nullptr, 0};
      run_gemm<0>(lds, XB, (const u16*)(ws + WS_WIN), T, NIN, D, E); }
    grid.sync();
    PH(2) for (int u = bx; u < 256; u += G) ssd_A_unit(P, lds, u >> 7, (u >> 1) & 63, u & 1);
    PH(3) for (int u = bx; u < 2048; u += G) lru_unit<false>(P, lds, u >> 10, (u >> 4) & 63, u & 15);
    grid.sync();
    PH(4) scan_phase(P);
    grid.sync();
    PH(5) for (int u = bx; u < 256; u += G) ssd_C_unit(P, lds, u >> 7, (u >> 1) & 63, u & 1);
    PH(6) for (int u = bx; u < 2048; u += G) lru_unit<true>(P, lds, u >> 10, (u >> 4) & 63, u & 15);
    grid.sync();
    PH(7) { Epi<1> E{nullptr, nullptr, nullptr, P.out, P.in[0], 0};
      run_gemm<1>(lds, ZG, (const u16*)(ws + WS_WOUT), T, D, 2048, E); }
    grid.sync();
    PH(8) ln_phase(P.out, P.in[24], P.in[25], P.out, XB);
    grid.sync();
    PH(9) { Epi<2> E{HB, nullptr, nullptr, nullptr, nullptr, FF};
      run_gemm<2>(lds, XB, (const u16*)(ws + WS_W1), T, FF, D, E); }
    grid.sync();
    { Epi<1> E{nullptr, nullptr, nullptr, P.out, P.out, 0};
      run_gemm<1>(lds, HB, (const u16*)(ws + WS_W2), T, D, FF, E); }
    grid.sync();
    ln_phase(P.out, P.in[28], P.in[29], P.out, XB);
    grid.sync();
    PH(10) { Epi<3> E{(u16*)(ws + WS_QK), nullptr, nullptr, nullptr, (const float*)(ws + WS_ROPE), 0};
      run_gemm<3>(lds, XB, (const u16*)(ws + WS_WQKV), T, 2048, D, E); }
    PH(11) { Epi<4> E{(u16*)(ws + WS_VT), nullptr, nullptr, nullptr, nullptr, T};
      run_gemm<4>(lds, (const u16*)(ws + WS_WQKV) + (size_t)2048 * D, XB, D, T, D, E); }
    grid.sync();
    PH(12) attn_phase(P, lds);
    grid.sync();
    { Epi<1> E{nullptr, nullptr, nullptr, P.out, P.out, 0};
      run_gemm<1>(lds, (const u16*)(ws + WS_O), (const u16*)(ws + WS_WAO), T, D, D, E); }
    grid.sync();
    ln_phase(P.out, P.in[24] + D, P.in[25] + D, P.out, XB);
    grid.sync();
    { Epi<2> E{HB, nullptr, nullptr, nullptr, nullptr, FF};
      run_gemm<2>(lds, XB, (const u16*)(ws + WS_W1) + (size_t)FF * D, T, FF, D, E); }
    grid.sync();
    { Epi<1> E{nullptr, nullptr, nullptr, P.out, P.out, 0};
      run_gemm<1>(lds, HB, (const u16*)(ws + WS_W2) + (size_t)FF * D, T, D, FF, E); }
    grid.sync();
    ln_phase(P.out, P.in[28] + D, P.in[29] + D, P.out, nullptr);
}

extern "C" void kernel_launch(void* const* d_in, const int* in_sizes, int n_in, void* d_out, int out_size, void* d_ws, size_t ws_size, hipStream_t stream) {
    static int grid = 0;
    if (grid == 0) {
        if (n_in != 30 || in_sizes[0] != T * D || out_size != T * D || ws_size < WS_END) { fprintf(stderr, "kernel_launch: unexpected shapes (n_in %d in0 %d out %d ws %zu)\n", n_in, n_in > 0 ? in_sizes[0] : -1, out_size, ws_size); grid = -1; return; }
        int dev = 0, cus = 0, per_cu = 0;
        hipGetDevice(&dev); hipDeviceGetAttribute(&cus, hipDeviceAttributeMultiprocessorCount, dev);
        hipFuncSetAttribute((const void*)hybrid_fwd, hipFuncAttributeMaxDynamicSharedMemorySize, LDS_BYTES);
        hipOccupancyMaxActiveBlocksPerMultiprocessor(&per_cu, (const void*)hybrid_fwd, 512, LDS_BYTES);
        if (per_cu < 1) { fprintf(stderr, "kernel_launch: occupancy query says %d blocks per CU\n", per_cu); per_cu = 1; }
        (void)hipGetLastError();
        grid = cus;
    }
    if (grid < 0) return;
    Params p{};
    for (int i = 0; i < 30; ++i) p.in[i] = (const float*)d_in[i];
    p.out = (float*)d_out; p.ws = (unsigned char*)d_ws;
    void* args[] = {&p};
    hipError_t e = hipLaunchCooperativeKernel((const void*)hybrid_fwd, dim3(grid), dim3(512), args, LDS_BYTES, stream);
    if (e != hipSuccess) fprintf(stderr, "cooperative launch failed: %s (grid %d)\n", hipGetErrorString(e), grid);
}
```

```cpp
#include <hip/hip_runtime.h>
#include <hip/hip_cooperative_groups.h>
#include <cstdio>
#include <cstdint>
#include <cmath>
namespace cg = cooperative_groups;
namespace pg8 {
#define PG8_LAS __attribute__((address_space(3)))
typedef unsigned short bf16_t;
typedef short bf16x8 __attribute__((ext_vector_type(8)));
typedef float f32x4 __attribute__((ext_vector_type(4)));
typedef unsigned u32x4 __attribute__((ext_vector_type(4)));
constexpr int BM = 256, BK = 64, HALF = 128, HTB = HALF * BK * 2  , STAGE_BYTES = 8 * HTB, NXCD = 8, WGM = 8;

__host__ __device__ __forceinline__ int lds_byte(int r, int c) { const int st = (r >> 4) * 2 + (c >> 5), rr = r & 15, cc = c & 31, ob = rr * 64 + cc * 2; return st * 1024 + (ob ^ (((ob >> 9) & 1) << 5)); }
__host__ __device__ __forceinline__ void stage_rc(int b, int& R, int& C) { const int st = b / 1024, sb = b % 1024, swz = sb ^ (((sb >> 9) & 1) << 5); R = (st >> 1) * 16 + swz / 64; C = (st & 1) * 32 + (swz % 64) / 2; }
__host__ __device__ __forceinline__ int perm32(int rho) { const int n = rho >> 4, i = rho & 15; return 8 * (i >> 2) + 4 * n + (i & 3); }

struct Unit { int pm, pn; };
struct Gemm { const bf16_t* A; const bf16_t* Bt; int M, N, K; };

struct StaticOrder {
    int nM, nN, nwg, G, c;
    __host__ __device__ void init(int M, int N, int G_, int c_) { nM = M / BM; nN = N / BM; nwg = nM * nN; G = G_; c = c_; }
    __host__ __device__ bool next(int i, Unit& u) const {
        const long L = (long)i * G + c; if (L >= nwg) return false;
        int wgid = (int)L; { const int q = nwg / NXCD, r = nwg % NXCD, xcd = wgid % NXCD, off = wgid / NXCD; wgid = (xcd < r ? xcd * (q + 1) : r * (q + 1) + (xcd - r) * q) + off; }
        const int nig = WGM * nN, gid = wgid / nig, fm = gid * WGM, gsz = (nM - fm) < WGM ? (nM - fm) : WGM;
        u.pm = fm + ((wgid % nig) % gsz); u.pn = (wgid % nig) / gsz; return true;
    }
    __device__ __forceinline__ void a_ready(const Unit&) const {}
    __device__ __forceinline__ void done(const Unit&) const {}
};

__device__ __forceinline__ unsigned cvt_pk_bf16(float lo, float hi) { unsigned r; asm volatile("v_cvt_pk_bf16_f32 %0, %1, %2" : "=v"(r) : "v"(lo), "v"(hi)); return r; }
typedef float f32x2 __attribute__((ext_vector_type(2)));
template <class Epi, class Sched, bool ALIGN_EPI = false, bool SP2 = false>
__device__ __forceinline__ void gemm_phase(PG8_LAS unsigned char* lds, const Gemm g, const Sched& S, const Epi& E) {
    int tid_o = threadIdx.x; asm volatile("" : "+v"(tid_o));
    const int tid = tid_o, wid = __builtin_amdgcn_readfirstlane(tid >> 6), lane = tid & 63, wr = wid >> 2, wc = wid & 3, fr = lane & 15, fq = lane >> 4;
    const int K = g.K, nt = K / BK;
    unsigned voffA[2], voffB[2];
#pragma unroll
    for (int i = 0; i < 2; ++i) { int R, C; stage_rc(tid * 16 + i * 8192, R, C); const int Rb = Epi::PERM ? ((R & ~31) + perm32(R & 31)) : R;
        voffA[i] = (unsigned)(R * K + C) * 2u; voffB[i] = (unsigned)(Rb * K + C) * 2u; }
    const size_t kstep = (size_t)(BK * 2);
    const size_t hstep = (size_t)HALF * K * 2;
    const size_t tstep = 2 * hstep;
    const unsigned ldsw = (unsigned)wid * 1024u;
    const int aoff = lds_byte(wr * 64 + fr, fq * 8), boff = lds_byte(wc * 32 + fr, fq * 8);
#define PG8_SA(b, h) (((b) * 2 + (h)) * HTB)
#define PG8_SB(b, h) ((4 + (b) * 2 + (h)) * HTB)
#define PG8_STAGE(bufoff, gbase, voff) do { _Pragma("unroll") for (int _i = 0; _i < 2; ++_i) \
        __builtin_amdgcn_global_load_lds((const unsigned*)((const char*)(gbase) + (voff)[_i]), (PG8_LAS unsigned*)(lds + (bufoff) + ldsw + _i * 8192), 16, 0, 0); } while (0)
#define PG8_LDA(dst, b, h) do { _Pragma("unroll") for (int m = 0; m < 4; ++m) _Pragma("unroll") for (int k = 0; k < 2; ++k) dst[m][k] = *(const PG8_LAS bf16x8*)(lds + PG8_SA(b, h) + aoff + m * 2048 + k * 1024); } while (0)
#define PG8_LDB(dst, b, h) do { _Pragma("unroll") for (int n = 0; n < 2; ++n) _Pragma("unroll") for (int k = 0; k < 2; ++k) dst[n][k] = *(const PG8_LAS bf16x8*)(lds + PG8_SB(b, h) + boff + n * 2048 + k * 1024); } while (0)
#define PG8_MMA(ai, bj, At, Bt) do { __builtin_amdgcn_s_setprio(1); _Pragma("unroll") for (int m = 0; m < 4; ++m) _Pragma("unroll") for (int n = 0; n < 2; ++n) _Pragma("unroll") for (int k = 0; k < 2; ++k) \
        acc[ai][bj][m][n] = __builtin_amdgcn_mfma_f32_16x16x32_bf16(Bt[n][k], At[m][k], acc[ai][bj][m][n], 0, 0, 0); __builtin_amdgcn_s_setprio(0); } while (0)
#define PG8_WAIT_V(n) asm volatile("s_waitcnt vmcnt(" #n ")" ::: "memory")
#define PG8_WAIT_L(n) asm volatile("s_waitcnt lgkmcnt(" #n ")" ::: "memory")
#define PG8_BAR __builtin_amdgcn_s_barrier()
#define PG8_SCHED __builtin_amdgcn_sched_barrier(0)
    Unit cur, nxt; int ui = 0;
    if (!S.next(0, cur)) return;
    f32x4 acc[2][2][4][2];
#pragma unroll
    for (int a = 0; a < 2; ++a)
#pragma unroll
        for (int b = 0; b < 2; ++b)
#pragma unroll
            for (int m = 0; m < 4; ++m)
#pragma unroll
                for (int n = 0; n < 2; ++n) acc[a][b][m][n] = (f32x4){0.f, 0.f, 0.f, 0.f};
    bf16x8 At[4][2], B0[2][2], B1[2][2];
    const char* cA = (const char*)g.A + (size_t)cur.pm * tstep; const char* cB = (const char*)g.Bt + (size_t)cur.pn * tstep;
    S.a_ready(cur);
    if constexpr (SP2) {
        PG8_STAGE(PG8_SB(0, 0), cB, voffB); PG8_STAGE(PG8_SB(0, 1), cB + hstep, voffB); PG8_STAGE(PG8_SA(0, 0), cA, voffA); PG8_STAGE(PG8_SA(0, 1), cA + hstep, voffA);
        if (wr == 1) PG8_BAR;
        PG8_WAIT_V(2); PG8_BAR;
        PG8_STAGE(PG8_SB(1, 0), cB + kstep, voffB); PG8_STAGE(PG8_SA(1, 0), cA + kstep, voffA); PG8_STAGE(PG8_SB(1, 1), cB + hstep + kstep, voffB);
        PG8_WAIT_V(6); PG8_BAR;
    } else {
        PG8_STAGE(PG8_SB(0, 0), cB, voffB); PG8_STAGE(PG8_SA(0, 0), cA, voffA); PG8_STAGE(PG8_SB(0, 1), cB + hstep, voffB); PG8_STAGE(PG8_SA(0, 1), cA + hstep, voffA);
        if (wr == 1) PG8_BAR;
        PG8_WAIT_V(4); PG8_BAR;
        PG8_STAGE(PG8_SB(1, 0), cB + kstep, voffB); PG8_STAGE(PG8_SA(1, 0), cA + kstep, voffA); PG8_STAGE(PG8_SB(1, 1), cB + hstep + kstep, voffB);
        PG8_WAIT_V(6); PG8_BAR;
    }
    for (;;) {
        const bool has_next = S.next(ui + 1, nxt);
        const char* nA = has_next ? (const char*)g.A + (size_t)nxt.pm * tstep : cA; const char* nB = has_next ? (const char*)g.Bt + (size_t)nxt.pn * tstep : cB;
        for (int t = 0; t < nt; t += 2) {
            const bool last = (t == nt - 2);
            const char* a1 = cA + (size_t)(t + 1) * kstep;
            const char* a2 = last ? nA : cA + (size_t)(t + 2) * kstep; const char* b2 = last ? nB : cB + (size_t)(t + 2) * kstep;
            const char* a3 = a2 + kstep; const char* b3 = b2 + kstep;
            if (last && has_next) S.a_ready(nxt);
            if constexpr (SP2) {
            PG8_LDB(B0, 0, 0); PG8_LDB(B1, 0, 1); PG8_SCHED; PG8_LDA(At, 0, 0); PG8_STAGE(PG8_SA(1, 1), a1 + hstep, voffA);
            PG8_WAIT_V(8); PG8_WAIT_L(0); PG8_BAR; PG8_MMA(0, 0, At, B0); PG8_MMA(0, 1, At, B1); PG8_BAR; PG8_SCHED;
            PG8_LDA(At, 0, 1); PG8_STAGE(PG8_SB(0, 0), b2, voffB); PG8_STAGE(PG8_SB(0, 1), b2 + hstep, voffB); PG8_STAGE(PG8_SA(0, 0), a2, voffA);
            PG8_WAIT_V(8); PG8_WAIT_L(0); PG8_BAR; PG8_MMA(1, 0, At, B0); PG8_MMA(1, 1, At, B1); PG8_BAR; PG8_SCHED;
            PG8_LDB(B0, 1, 0); PG8_LDB(B1, 1, 1); PG8_SCHED; PG8_LDA(At, 1, 0); PG8_STAGE(PG8_SA(0, 1), a2 + hstep, voffA);
            PG8_WAIT_V(8); PG8_WAIT_L(0); PG8_BAR; PG8_MMA(0, 0, At, B0); PG8_MMA(0, 1, At, B1); PG8_BAR; PG8_SCHED;
            PG8_LDA(At, 1, 1); PG8_STAGE(PG8_SB(1, 0), b3, voffB); PG8_STAGE(PG8_SB(1, 1), b3 + hstep, voffB); PG8_STAGE(PG8_SA(1, 0), a3, voffA);
            PG8_WAIT_V(8); PG8_WAIT_L(0); PG8_BAR; PG8_MMA(1, 0, At, B0); PG8_MMA(1, 1, At, B1); PG8_BAR; PG8_SCHED;
            } else {
            PG8_LDB(B0, 0, 0); PG8_SCHED; PG8_LDA(At, 0, 0); PG8_STAGE(PG8_SA(1, 1), a1 + hstep, voffA);
            PG8_WAIT_L(8); PG8_BAR; PG8_WAIT_L(0); PG8_MMA(0, 0, At, B0); PG8_BAR; PG8_SCHED;
            PG8_LDB(B1, 0, 1); PG8_STAGE(PG8_SB(0, 0), b2, voffB);
            PG8_BAR; PG8_WAIT_L(0); PG8_MMA(0, 1, At, B1); PG8_BAR;
            PG8_LDA(At, 0, 1); PG8_STAGE(PG8_SA(0, 0), a2, voffA);
            PG8_BAR; PG8_WAIT_L(0); PG8_MMA(1, 0, At, B0); PG8_BAR; PG8_SCHED;
            PG8_STAGE(PG8_SB(0, 1), b2 + hstep, voffB);
            PG8_WAIT_V(6); PG8_BAR; PG8_MMA(1, 1, At, B1); PG8_BAR;
            PG8_LDB(B0, 1, 0); PG8_SCHED; PG8_LDA(At, 1, 0); PG8_STAGE(PG8_SA(0, 1), a2 + hstep, voffA);
            PG8_WAIT_L(8); PG8_BAR; PG8_WAIT_L(0); PG8_MMA(0, 0, At, B0); PG8_BAR; PG8_SCHED;
            PG8_LDB(B1, 1, 1); PG8_STAGE(PG8_SB(1, 0), b3, voffB);
            PG8_BAR; PG8_WAIT_L(0); PG8_MMA(0, 1, At, B1); PG8_BAR;
            PG8_LDA(At, 1, 1); PG8_STAGE(PG8_SA(1, 0), a3, voffA);
            PG8_BAR; PG8_WAIT_L(0); PG8_MMA(1, 0, At, B0); PG8_BAR; PG8_SCHED;
            PG8_STAGE(PG8_SB(1, 1), b3 + hstep, voffB);
            PG8_WAIT_V(6); PG8_BAR; PG8_MMA(1, 1, At, B1); PG8_BAR;
            }
        }
        if constexpr (ALIGN_EPI) { if (wr == 0) PG8_BAR; }
        if constexpr (!Epi::AFTER_DRAIN) { E(acc, cur, wr, wc, fr, fq); S.done(cur); }
        if (!has_next) break;
#pragma unroll
        for (int a = 0; a < 2; ++a)
#pragma unroll
            for (int b = 0; b < 2; ++b)
#pragma unroll
                for (int m = 0; m < 4; ++m)
#pragma unroll
                    for (int n = 0; n < 2; ++n) acc[a][b][m][n] = (f32x4){0.f, 0.f, 0.f, 0.f};
        cur = nxt; cA = nA; cB = nB; ++ui;
        if constexpr (ALIGN_EPI) { if (wr == 1) PG8_BAR; }
    }
    PG8_WAIT_V(0);
    if constexpr (!ALIGN_EPI) { if (wr == 0) PG8_BAR; }
    PG8_BAR;
    if constexpr (Epi::AFTER_DRAIN) { E.fused(acc, cur, wr, wc, fr, fq, lds, wid, lane); S.done(cur); }
#undef PG8_SA
#undef PG8_SB
#undef PG8_STAGE
#undef PG8_LDA
#undef PG8_LDB
#undef PG8_MMA
#undef PG8_WAIT_V
#undef PG8_WAIT_L
#undef PG8_BAR
#undef PG8_SCHED
}
}

typedef unsigned short u16;
typedef short bf16x8 __attribute__((ext_vector_type(8)));
typedef short bf16x4 __attribute__((ext_vector_type(4)));
typedef float f32x4 __attribute__((ext_vector_type(4)));
typedef float f32x2 __attribute__((ext_vector_type(2)));
typedef float f32x16 __attribute__((ext_vector_type(16)));
typedef unsigned u32x4 __attribute__((ext_vector_type(4)));
typedef unsigned u32x2 __attribute__((ext_vector_type(2)));

constexpr int SEQ = 8192, NB = 2, T = NB * SEQ, D = 1024, FF = 4096;
constexpr int NIN = 4864;
constexpr int IN_COLS = 4624;
constexpr float ALPHA = 1.41421356237f, LN_EPS = 1e-5f;
constexpr float LAMBDA_INIT = 0.35550906759f;
constexpr float QSCALE = 0.125f * 1.4426950408889634f;
constexpr size_t MiB = 1u << 20;
constexpr size_t WS_WIN = 0;
constexpr size_t WS_WOUT = WS_WIN + (size_t)NIN * D * 2;
constexpr size_t WS_W1 = WS_WOUT + (size_t)D * 2048 * 2;
constexpr size_t WS_W2 = WS_W1 + 2 * (size_t)FF * D * 2;
constexpr size_t WS_WQKV = WS_W2 + 2 * (size_t)FF * D * 2;
constexpr size_t WS_WAO = WS_WQKV + (size_t)3072 * D * 2;
constexpr size_t WS_WEND = WS_WAO + (size_t)D * D * 2;
static_assert(WS_WEND <= 54 * MiB, "weights");
constexpr size_t WS_DT = 54 * MiB;
constexpr size_t WS_ROPE = 55 * MiB;
constexpr size_t WS_CDEC = 56 * MiB;
constexpr size_t WS_LCA = 56 * MiB + 65536;
constexpr size_t WS_LCH = WS_LCA + 524288;
constexpr size_t WS_ZG = 58 * MiB;
constexpr size_t WS_XBC = 122 * MiB;
constexpr size_t WS_XL = 170 * MiB;
constexpr size_t WS_XB = 202 * MiB;
constexpr size_t WS_END = 234 * MiB;
constexpr size_t WS_H = 58 * MiB;
constexpr size_t WS_QK = 58 * MiB;
constexpr size_t WS_VT = 122 * MiB;
constexpr size_t WS_O = 154 * MiB;
constexpr size_t WS_BAR = 57 * MiB + 524288;
static_assert(WS_LCH + 524288 <= WS_BAR && WS_BAR + 16384 <= WS_ZG, "misc map");
constexpr int LDS_BYTES = 147456, MISC_OFF = 131072;

struct Params { const float* in[30]; float* out; unsigned char* ws; };

__device__ __forceinline__ unsigned f2bf(float f) { unsigned u = __builtin_bit_cast(unsigned, f); return (u + 0x7fffu + ((u >> 16) & 1u)) >> 16; }
__device__ __forceinline__ unsigned pk2(float lo, float hi) { return f2bf(lo) | (f2bf(hi) << 16); }
__device__ __forceinline__ float bf2f(unsigned v) { return __builtin_bit_cast(float, v << 16); }
__device__ __forceinline__ float bflo(unsigned w) { return __builtin_bit_cast(float, w << 16); }
__device__ __forceinline__ float bfhi(unsigned w) { return __builtin_bit_cast(float, w & 0xffff0000u); }
__device__ __forceinline__ int crow(int r, int hi) { return (r & 3) + 8 * (r >> 2) + 4 * hi; }
__device__ __forceinline__ f32x16 mfma32(bf16x8 a, bf16x8 b, f32x16 c) { return __builtin_amdgcn_mfma_f32_32x32x16_bf16(a, b, c, 0, 0, 0); }
__device__ __forceinline__ float softplusf(float x) { return x > 20.f ? x : log1pf(expf(x)); }
__device__ __forceinline__ float sigmoidf(float x) { return 1.f / (1.f + expf(-x)); }
__device__ __forceinline__ float fexp(float x) { return __builtin_amdgcn_exp2f(x * 1.4426950408889634f); }
__device__ __forceinline__ int opaque_tid() { int t = threadIdx.x; asm volatile("" : "+v"(t)); return t; }
__device__ __forceinline__ f32x16 zero16() { f32x16 z; for (int i = 0; i < 16; ++i) z[i] = 0.f; return z; }

template <int MODE> struct Epi {
    static constexpr bool PERM = true, AFTER_DRAIN = false;
    u16* o0; u16* o1; u16* o2; float* f0; const float* base; int ldc;
    __device__ __forceinline__ void operator()(const pg8::f32x4 (&acc)[2][2][4][2], const pg8::Unit& u, int wr, int wc, int fr, int fq) const {
#pragma unroll
        for (int ai = 0; ai < 2; ++ai)
#pragma unroll
            for (int m = 0; m < 4; ++m) {
                const int row = u.pm * 256 + ai * 128 + wr * 64 + m * 16 + fr;
#pragma unroll
                for (int bj = 0; bj < 2; ++bj) {
                    const int col0 = u.pn * 256 + bj * 128 + wc * 32 + 8 * fq;
                    f32x4 v0 = acc[ai][bj][m][0], v1 = acc[ai][bj][m][1];
                    if (MODE == 0) {
                        u16* dst;
                        if (u.pn < 8) dst = o0 + (size_t)row * 2048 + col0;
                        else if (u.pn < 14) dst = o1 + (size_t)row * 1536 + (col0 - 2048);
                        else if (u.pn < 18) dst = o2 + (size_t)row * 1024 + (col0 - 3584);
                        else { if (col0 < 4624) { float* d = f0 + (size_t)row * 16 + (col0 - 4608); *(f32x4*)d = v0; *(f32x4*)(d + 4) = v1; } continue; }
                        u32x4 w; w.x = pk2(v0[0], v0[1]); w.y = pk2(v0[2], v0[3]); w.z = pk2(v1[0], v1[1]); w.w = pk2(v1[2], v1[3]);
                        *(u32x4*)dst = w;
                    } else if (MODE == 1) {
                        const float* bs = base + (size_t)row * 1024 + col0; float* o = f0 + (size_t)row * 1024 + col0;
                        const f32x4 b0 = *(const f32x4*)bs, b1 = *(const f32x4*)(bs + 4);
                        *(f32x4*)o = b0 * ALPHA + v0; *(f32x4*)(o + 4) = b1 * ALPHA + v1;
                    } else if (MODE == 2) {
#pragma unroll
                        for (int i = 0; i < 4; ++i) { float a = fmaxf(v0[i], 0.f), b = fmaxf(v1[i], 0.f); v0[i] = a * a; v1[i] = b * b; }
                        u32x4 w; w.x = pk2(v0[0], v0[1]); w.y = pk2(v0[2], v0[3]); w.z = pk2(v1[0], v1[1]); w.w = pk2(v1[2], v1[3]);
                        *(u32x4*)(o0 + (size_t)row * ldc + col0) = w;
                    } else if (MODE == 3) {
                        if ((wc & 1) == 0) {
                            f32x4 p0, p1;
#pragma unroll
                            for (int i = 0; i < 4; ++i) { p0[i] = __shfl_xor(v0[i], 16); p1[i] = __shfl_xor(v1[i], 16); }
                            if (fq < 2) {
                                const float* rp = base + (size_t)row * 16;
                                const f32x4 c0 = *(const f32x4*)rp, c1 = *(const f32x4*)(rp + 4), s0 = *(const f32x4*)(rp + 8), s1 = *(const f32x4*)(rp + 12);
                                if (fq == 0) { v0 = v0 * c0 - p0 * s0; v1 = v1 * c1 - p1 * s1; }
                                else { v0 = v0 * c0 + p0 * s0; v1 = v1 * c1 + p1 * s1; }
                            }
                        }
                        if (col0 < 1024) { v0 = v0 * QSCALE; v1 = v1 * QSCALE; }
                        u32x4 w; w.x = pk2(v0[0], v0[1]); w.y = pk2(v0[2], v0[3]); w.z = pk2(v1[0], v1[1]); w.w = pk2(v1[2], v1[3]);
                        *(u32x4*)(o0 + (size_t)row * 2048 + col0) = w;
                    } else {
                        u32x4 w; w.x = pk2(v0[0], v0[1]); w.y = pk2(v0[2], v0[3]); w.z = pk2(v1[0], v1[1]); w.w = pk2(v1[2], v1[3]);
                        *(u32x4*)(o0 + (size_t)row * ldc + col0) = w;
                    }
                }
            }
    }
};

template <int MODE> __device__ __forceinline__ void run_gemm(unsigned char* lds, const u16* A, const u16* Bt, int M, int N, int K, const Epi<MODE>& E) {
    pg8::Gemm g{A, Bt, M, N, K}; pg8::StaticOrder S; S.init(M, N, (int)gridDim.x, (int)blockIdx.x);
    pg8::gemm_phase<Epi<MODE>, pg8::StaticOrder, true, true>((PG8_LAS unsigned char*)lds, g, S, E);
    __syncthreads();
}

__device__ __forceinline__ int win_src_col(int n) {
    if (n < 1024) return n;
    if (n < 2048) return n - 1024 + 2576;
    if (n < 3584) return n - 2048 + 1024;
    if (n < 4608) return n - 3584 + 3600;
    if (n < 4624) return n - 4608 + 2560;
    return -1;
}
template <bool MAP> __device__ __forceinline__ void transpose_item(const float* W, int K, int Nsrc, int nblk, u16* WT, float* scr, int item, int lane) {
    const int kb = item / nblk, nb = item % nblk, k0 = 64 * kb, n0 = 32 * nb;
    const int nn = n0 + (lane & 31); const int sc = MAP ? win_src_col(nn) : nn;
#pragma unroll 8
    for (int i = 0; i < 32; ++i) { const int kk = 2 * i + (lane >> 5); scr[kk * 33 + (lane & 31)] = sc >= 0 ? W[(size_t)(k0 + kk) * Nsrc + sc] : 0.f; }
    __builtin_amdgcn_s_waitcnt(0xc07f); asm volatile("" ::: "memory");
    const int c = lane & 7;
#pragma unroll
    for (int j = 0; j < 4; ++j) { const int n = (lane >> 3) + 8 * j; const float* s = scr + (8 * c) * 33 + n;
        u32x4 o; o.x = pk2(s[0 * 33], s[1 * 33]); o.y = pk2(s[2 * 33], s[3 * 33]); o.z = pk2(s[4 * 33], s[5 * 33]); o.w = pk2(s[6 * 33], s[7 * 33]);
        *(u32x4*)(WT + (size_t)(n0 + n) * K + k0 + 8 * c) = o; }
    __builtin_amdgcn_s_waitcnt(0xc07f); asm volatile("" ::: "memory");
}
__device__ __forceinline__ float wave_sum(float v) {
#pragma unroll
    for (int o = 1; o < 64; o <<= 1) v += __shfl_xor(v, o);
    return v;
}
__device__ __forceinline__ void ln_phase(const float* v, const float* g, const float* bt, float* outf, u16* outb) {
    const int tid = opaque_tid(), lane = tid & 63, wave = tid >> 6;
    const int gw = blockIdx.x * 8 + wave, NGW = gridDim.x * 8;
    f32x4 gg[4], bb[4];
#pragma unroll
    for (int j = 0; j < 4; ++j) { gg[j] = *((const f32x4*)g + lane + 64 * j); bb[j] = *((const f32x4*)bt + lane + 64 * j); }
    for (int m = gw; m < T; m += NGW) {
        const f32x4* xr = (const f32x4*)(v + (size_t)m * D) + lane;
        f32x4 x[4]; float s = 0.f;
#pragma unroll
        for (int j = 0; j < 4; ++j) { x[j] = xr[64 * j]; s += (x[j].x + x[j].y) + (x[j].z + x[j].w); }
        const float mean = wave_sum(s) * (1.f / D); float s2 = 0.f;
#pragma unroll
        for (int j = 0; j < 4; ++j) { x[j] = x[j] - mean; s2 += (x[j].x * x[j].x + x[j].y * x[j].y) + (x[j].z * x[j].z + x[j].w * x[j].w); }
        const float rstd = 1.f / sqrtf(wave_sum(s2) * (1.f / D) + LN_EPS);
#pragma unroll
        for (int j = 0; j < 4; ++j) x[j] = x[j] * rstd * gg[j] + bb[j];
        if (outf) { f32x4* o = (f32x4*)(outf + (size_t)m * D) + lane;
#pragma unroll
            for (int j = 0; j < 4; ++j) o[64 * j] = x[j]; }
        if (outb) { u32x2* o = (u32x2*)(outb + (size_t)m * D) + lane;
#pragma unroll
            for (int j = 0; j < 4; ++j) { u32x2 w; w.x = pk2(x[j].x, x[j].y); w.y = pk2(x[j].z, x[j].w); o[64 * j] = w; } }
    }
}

__device__ __forceinline__ void prologue(const Params& P, unsigned char* lds) {
    const int tid = opaque_tid(), lane = tid & 63, wave = tid >> 6;
    float* scr = (float*)(lds + wave * 16384);
    const int gw = blockIdx.x * 8 + wave, NGW = gridDim.x * 8;
    unsigned char* ws = P.ws;
    constexpr int I_IN = (D / 64) * (NIN / 32), I_OUT = (2048 / 64) * (D / 32), I_1 = (D / 64) * (FF / 32), I_2 = (FF / 64) * (D / 32), I_QKV = (D / 64) * (3072 / 32), I_AO = (D / 64) * (D / 32);
    constexpr int NITEMS = I_IN + I_OUT + 2 * I_1 + 2 * I_2 + I_QKV + I_AO;
    for (int it = gw; it < NITEMS; it += NGW) {
        int r = it;
        if (r < I_IN) { transpose_item<true>(P.in[2], D, IN_COLS, NIN / 32, (u16*)(ws + WS_WIN), scr, r, lane); continue; } r -= I_IN;
        if (r < I_OUT) { transpose_item<false>(P.in[16], 2048, D, D / 32, (u16*)(ws + WS_WOUT), scr, r, lane); continue; } r -= I_OUT;
        if (r < I_1) { transpose_item<false>(P.in[26], D, FF, FF / 32, (u16*)(ws + WS_W1), scr, r, lane); continue; } r -= I_1;
        if (r < I_1) { transpose_item<false>(P.in[26] + (size_t)D * FF, D, FF, FF / 32, (u16*)(ws + WS_W1) + (size_t)FF * D, scr, r, lane); continue; } r -= I_1;
        if (r < I_2) { transpose_item<false>(P.in[27], FF, D, D / 32, (u16*)(ws + WS_W2), scr, r, lane); continue; } r -= I_2;
        if (r < I_2) { transpose_item<false>(P.in[27] + (size_t)D * FF, FF, D, D / 32, (u16*)(ws + WS_W2) + (size_t)FF * D, scr, r, lane); continue; } r -= I_2;
        if (r < I_QKV) { transpose_item<false>(P.in[17], D, 3072, 3072 / 32, (u16*)(ws + WS_WQKV), scr, r, lane); continue; } r -= I_QKV;
        transpose_item<false>(P.in[23], D, D, D / 32, (u16*)(ws + WS_WAO), scr, r, lane);
    }
    for (int m = gw; m < T; m += NGW) {
        const f32x4* xr = (const f32x4*)(P.in[0] + (size_t)m * D) + lane; u32x2* o = (u32x2*)((u16*)(ws + WS_XB) + (size_t)m * D) + lane;
#pragma unroll
        for (int j = 0; j < 4; ++j) { const f32x4 x = xr[64 * j]; u32x2 w; w.x = pk2(x.x, x.y); w.y = pk2(x.z, x.w); o[64 * j] = w; }
    }
    const int* pos = (const int*)P.in[1]; float* rope = (float*)(ws + WS_ROPE);
    for (int e = blockIdx.x * 512 + tid; e < T * 8; e += gridDim.x * 512) {
        const int tok = e >> 3, i = e & 7;
        const float inv = powf(500000.0f, -(float)i * 0.125f);
        const float ang = (float)pos[tok] * inv;
        rope[tok * 16 + i] = cosf(ang); rope[tok * 16 + 8 + i] = sinf(ang);
    }
}

template <int NCH, int ROWS, bool SILU, bool TRANS>
__device__ __forceinline__ void conv_tile(const u16* src, int ld, int col0, const float* cw, const float* cb, int cld, size_t tokbase, int t0,
                                          unsigned char* dst, int RS, const float* rowscale, int tid) {
    static_assert(NCH * (128 / ROWS) == 512, "all 512 threads work");
    const int ch = tid % NCH, rg = tid / NCH, c0 = col0 + ch * 8;
    u32x4 in[ROWS + 3];
#pragma unroll
    for (int i = 0; i < ROWS + 3; ++i) { const int tr = t0 + rg * ROWS - 3 + i;
        if (tr >= 0) in[i] = *(const u32x4*)(src + (tokbase + tr) * ld + c0); else in[i] = (u32x4){0u, 0u, 0u, 0u}; }
    float out[ROWS][8];
#pragma unroll
    for (int hf = 0; hf < 2; ++hf) {
        f32x4 w[4];
#pragma unroll
        for (int k = 0; k < 4; ++k) w[k] = *(const f32x4*)(cw + (size_t)k * cld + c0 + 4 * hf);
        const f32x4 bias = *(const f32x4*)(cb + c0 + 4 * hf);
#pragma unroll
        for (int j = 0; j < ROWS; ++j) {
            const float rs = rowscale ? rowscale[rg * ROWS + j] : 1.f;
#pragma unroll
            for (int e = 0; e < 4; ++e) {
                float a = bias[e];
#pragma unroll
                for (int k = 0; k < 4; ++k) { const unsigned wd = in[j + k][2 * hf + (e >> 1)]; const float xv = (e & 1) ? bfhi(wd) : bflo(wd); a += w[k][e] * xv; }
                if (SILU) a = a / (1.f + expf(-a));
                out[j][4 * hf + e] = a * rs;
            }
        }
    }
    if (TRANS) {
#pragma unroll
        for (int e = 0; e < 8; ++e) {
            if (ROWS == 4) { u32x2 wv; wv.x = pk2(out[0][e], out[1][e]); wv.y = pk2(out[ROWS - 2][e], out[ROWS - 1][e]); *(u32x2*)(dst + (size_t)(ch * 8 + e) * RS + rg * 8) = wv; }
            else { *(unsigned*)(dst + (size_t)(ch * 8 + e) * RS + rg * 4) = pk2(out[0][e], out[1][e]); }
        }
    } else {
#pragma unroll
        for (int j = 0; j < ROWS; ++j) { u32x4 wv; wv.x = pk2(out[j][0], out[j][1]); wv.y = pk2(out[j][2], out[j][3]); wv.z = pk2(out[j][4], out[j][5]); wv.w = pk2(out[j][6], out[j][7]);
            *(u32x4*)(dst + (size_t)(rg * ROWS + j) * RS + ch * 16) = wv; }
    }
}

constexpr int R272 = 272;
__device__ __forceinline__ void ssd_dt_acum(const Params& P, float* s_dt, float* s_ac, int tok0, int g, int tid) {
    const float* dtraw = (const float*)(P.ws + WS_DT);
#pragma unroll
    for (int i = 0; i < 2; ++i) { const int idx = tid + 512 * i, hh = idx >> 7, l = idx & 127, hd = g * 8 + hh;
        s_dt[idx] = softplusf(dtraw[(size_t)(tok0 + l) * 16 + hd] + P.in[5][hd]); }
    __syncthreads();
#pragma unroll
    for (int i = 0; i < 2; ++i) { const int idx = tid + 512 * i, hh = idx >> 7, l = idx & 127, hd = g * 8 + hh;
        const float a = -expf(P.in[6][hd]); float s = 0.f;
        for (int q = 0; q <= l; ++q) s += s_dt[hh * 128 + q] * a;
        s_ac[idx] = s; }
    __syncthreads();
}

__device__ __forceinline__ void ssd_A_unit(const Params& P, unsigned char* lds, int b, int c, int g) {
    const int tid = opaque_tid(), lane = tid & 63, r32 = lane & 31, hi = lane >> 5, w = tid >> 6;
    unsigned char* BT = lds; unsigned char* XsT = lds + 34816;
    float* s_dt = (float*)(lds + 52224); float* s_ac = (float*)(lds + 56320); float* s_rs = (float*)(lds + 60416);
    const int tok0 = b * SEQ + c * 128;
    const u16* XBC = (const u16*)(P.ws + WS_XBC);
    ssd_dt_acum(P, s_dt, s_ac, tok0, g, tid);
    conv_tile<16, 4, true, true>(XBC, 1536, 1024 + g * 128, P.in[3], P.in[4], 1536, (size_t)b * SEQ, c * 128, BT, R272, nullptr, tid);
    for (int hh = 0; hh < 8; ++hh) {
        const int hd = g * 8 + hh;
        __syncthreads();
        if (tid < 128) s_rs[tid] = s_dt[hh * 128 + tid] * expf(s_ac[hh * 128 + 127] - s_ac[hh * 128 + tid]);
        __syncthreads();
        conv_tile<8, 2, true, true>(XBC, 1536, hd * 64, P.in[3], P.in[4], 1536, (size_t)b * SEQ, c * 128, XsT, R272, s_rs, tid);
        __syncthreads();
        const int mi = w >> 2, ni = w & 3;
        f32x16 acc = zero16();
#pragma unroll
        for (int k0 = 0; k0 < 8; ++k0) {
            const bf16x8 a = *(const bf16x8*)(XsT + (32 * mi + r32) * R272 + (16 * k0 + 8 * hi) * 2);
            const bf16x8 bb = *(const bf16x8*)(BT + (32 * ni + r32) * R272 + (16 * k0 + 8 * hi) * 2);
            acc = mfma32(a, bb, acc);
        }
        float* sp = P.out + ((size_t)(b * 64 + c) * 16 + hd) * 8192;
#pragma unroll
        for (int r = 0; r < 16; ++r) sp[(32 * mi + crow(r, hi)) * 128 + 32 * ni + r32] = acc[r];
        if (tid == 0) ((float*)(P.ws + WS_CDEC))[(b * 64 + c) * 16 + hd] = expf(s_ac[hh * 128 + 127]);
    }
    __syncthreads();
}

__device__ __forceinline__ void ssd_C_unit(const Params& P, unsigned char* lds, int b, int c, int g, u16* Y, int ldy) {
    const int tid = opaque_tid(), lane = tid & 63, r32 = lane & 31, hi = lane >> 5, w = tid >> 6;
    unsigned char* Cs = lds; unsigned char* Ms = lds + 34816; unsigned char* Ps = lds + 69632; unsigned char* Xt = lds + 87040;
    float* s_dt = (float*)(lds + 104448); float* s_ac = (float*)(lds + 108544); float* s_ssq = (float*)(lds + 112640);
    const int tok0 = b * SEQ + c * 128;
    const u16* XBC = (const u16*)(P.ws + WS_XBC); u16* ZG = (u16*)(P.ws + WS_ZG);
    if (tid < 128) s_ssq[tid] = 0.f;
    ssd_dt_acum(P, s_dt, s_ac, tok0, g, tid);
    conv_tile<16, 4, true, false>(XBC, 1536, 1280 + g * 128, P.in[3], P.in[4], 1536, (size_t)b * SEQ, c * 128, Cs, R272, nullptr, tid);
    conv_tile<16, 4, true, false>(XBC, 1536, 1024 + g * 128, P.in[3], P.in[4], 1536, (size_t)b * SEQ, c * 128, Ms, R272, nullptr, tid);
    __syncthreads();
    const int mi = w >> 1, nib = (w & 1) * 2;
    f32x16 cb[2];
#pragma unroll
    for (int t2 = 0; t2 < 2; ++t2) { const int ni = nib + t2; cb[t2] = zero16();
        if (ni <= mi) {
#pragma unroll
            for (int k0 = 0; k0 < 8; ++k0) {
                const bf16x8 a = *(const bf16x8*)(Cs + (32 * mi + r32) * R272 + (16 * k0 + 8 * hi) * 2);
                const bf16x8 bb = *(const bf16x8*)(Ms + (32 * ni + r32) * R272 + (16 * k0 + 8 * hi) * 2);
                cb[t2] = mfma32(a, bb, cb[t2]);
            } } }
    __syncthreads();
    unsigned cbp[2][8];
#pragma unroll
    for (int t2 = 0; t2 < 2; ++t2)
#pragma unroll
        for (int r = 0; r < 8; ++r) cbp[t2][r] = pk2(cb[t2][2 * r], cb[t2][2 * r + 1]);
    const int pt = w & 1;
#pragma unroll 1
    for (int hh = 0; hh < 8; ++hh) {
        const int hd = g * 8 + hh;
#pragma unroll
        for (int t2 = 0; t2 < 2; ++t2) { const int ni = nib + t2; const int s = 32 * ni + r32; const float acs = s_ac[hh * 128 + s], dts = s_dt[hh * 128 + s];
#pragma unroll
            for (int r = 0; r < 16; ++r) { const int l = 32 * mi + crow(r, hi);
                const float cbv = (r & 1) ? bfhi(cbp[t2][r >> 1]) : bflo(cbp[t2][r >> 1]);
                float v = 0.f; if (s <= l) v = cbv * fexp(s_ac[hh * 128 + l] - acs) * dts;
                *(u16*)(Ms + l * R272 + s * 2) = (u16)f2bf(v); } }
        conv_tile<8, 2, true, true>(XBC, 1536, hd * 64, P.in[3], P.in[4], 1536, (size_t)b * SEQ, c * 128, Xt, R272, nullptr, tid);
        { const float* sp = P.out + ((size_t)(b * 64 + c) * 16 + hd) * 8192;
#pragma unroll
            for (int i = 0; i < 4; ++i) { const int idx4 = tid + 512 * i, p = idx4 >> 5, n4 = (idx4 & 31) * 4; const f32x4 v = *(const f32x4*)(sp + p * 128 + n4);
                u32x2 wv; wv.x = pk2(v.x, v.y); wv.y = pk2(v.z, v.w); *(u32x2*)(Ps + p * R272 + n4 * 2) = wv; } }
        __syncthreads();
        f32x16 acc = zero16();
#pragma unroll
        for (int k0 = 0; k0 < 8; ++k0) {
            const bf16x8 a = *(const bf16x8*)(Cs + (32 * mi + r32) * R272 + (16 * k0 + 8 * hi) * 2);
            const bf16x8 bb = *(const bf16x8*)(Ps + (32 * pt + r32) * R272 + (16 * k0 + 8 * hi) * 2);
            acc = mfma32(a, bb, acc);
        }
#pragma unroll
        for (int r = 0; r < 16; ++r) acc[r] *= fexp(s_ac[hh * 128 + 32 * mi + crow(r, hi)]);
#pragma unroll
        for (int k0 = 0; k0 < 8; ++k0) {
            if (16 * k0 <= 32 * mi + 31) {
                const bf16x8 a = *(const bf16x8*)(Ms + (32 * mi + r32) * R272 + (16 * k0 + 8 * hi) * 2);
                const bf16x8 bb = *(const bf16x8*)(Xt + (32 * pt + r32) * R272 + (16 * k0 + 8 * hi) * 2);
                acc = mfma32(a, bb, acc);
            } }
        const float dsk = P.in[7][hd]; const int p = 32 * pt + r32;
#pragma unroll
        for (int r = 0; r < 16; ++r) { const int l = 32 * mi + crow(r, hi);
            const float xv = bf2f(*(const u16*)(Xt + p * R272 + l * 2));
            const float y = acc[r] + dsk * xv;
            u16* zp = Y + (size_t)(tok0 + l) * ldy + hd * 64 + p;
            const float z = bf2f(ZG[(size_t)(tok0 + l) * 2048 + hd * 64 + p]);
            const unsigned ygb = f2bf(y * z / (1.f + fexp(-z)));
            *zp = (u16)ygb;
            const float ygf = bf2f(ygb);
            float sq = ygf * ygf;
            sq += __shfl_xor(sq, 1); sq += __shfl_xor(sq, 2); sq += __shfl_xor(sq, 4); sq += __shfl_xor(sq, 8); sq += __shfl_xor(sq, 16);
            if (r32 == 0) atomicAdd(&s_ssq[l], sq); }
        __syncthreads();
    }
    float rs[16];
#pragma unroll
    for (int r = 0; r < 16; ++r) rs[r] = 1.f / sqrtf(s_ssq[32 * mi + crow(r, hi)] * (1.f / 512.f) + LN_EPS);
#pragma unroll 1
    for (int hh = 0; hh < 8; ++hh) { const int hd = g * 8 + hh, p = 32 * pt + r32; const float nw = P.in[8][hd * 64 + p];
#pragma unroll
        for (int r = 0; r < 16; ++r) { const int l = 32 * mi + crow(r, hi); u16* zp = Y + (size_t)(tok0 + l) * ldy + hd * 64 + p;
            const float yv = bf2f(*(volatile u16*)zp);
            *zp = (u16)f2bf(yv * rs[r] * nw); } }
    __syncthreads();
}

template <bool PHASE_C>
__device__ __forceinline__ void lru_unit(const Params& P, unsigned char* lds, int b, int c, int h, u16* Y, int ldy) {
    const int tid = opaque_tid(), lane = tid & 63, r32 = lane & 31, hi = lane >> 5, w = tid >> 6;
    unsigned char* Xs = lds; unsigned char* WaT = lds + 18432; unsigned char* WxT = lds + 27648;
    float* af = (float*)(lds + 36864); float* uf = (float*)(lds + 69632); float* segA = (float*)(lds + 102400); float* segH = (float*)(lds + 104448);
    const int tok0 = b * SEQ + c * 128;
    const u16* XL = (const u16*)(P.ws + WS_XL); u16* ZG = (u16*)(P.ws + WS_ZG);
    conv_tile<8, 2, false, false>(XL, 1024, h * 64, P.in[9], P.in[10], 1024, (size_t)b * SEQ, c * 128, Xs, 144, nullptr, tid);
    { const int i = tid >> 3, j0 = (tid & 7) * 8;
        const float* wa = P.in[11] + (size_t)h * 4096 + i * 64 + j0; const float* wx = P.in[13] + (size_t)h * 4096 + i * 64 + j0;
#pragma unroll
        for (int e4 = 0; e4 < 2; ++e4) { const f32x4 va = *(const f32x4*)(wa + 4 * e4), vx = *(const f32x4*)(wx + 4 * e4);
#pragma unroll
            for (int e = 0; e < 4; ++e) { *(u16*)(WaT + (j0 + 4 * e4 + e) * 144 + i * 2) = (u16)f2bf(va[e]); *(u16*)(WxT + (j0 + 4 * e4 + e) * 144 + i * 2) = (u16)f2bf(vx[e]); } } }
    __syncthreads();
    {
        const int mi = w >> 1, ni = w & 1;
        f32x16 accA = zero16(), accX = zero16();
#pragma unroll
        for (int k0 = 0; k0 < 4; ++k0) {
            const bf16x8 a = *(const bf16x8*)(Xs + (32 * mi + r32) * 144 + (16 * k0 + 8 * hi) * 2);
            const bf16x8 ba = *(const bf16x8*)(WaT + (32 * ni + r32) * 144 + (16 * k0 + 8 * hi) * 2);
            const bf16x8 bx = *(const bf16x8*)(WxT + (32 * ni + r32) * 144 + (16 * k0 + 8 * hi) * 2);
            accA = mfma32(a, ba, accA); accX = mfma32(a, bx, accX);
        }
        const int j = 32 * ni + r32, chn = h * 64 + j;
        const float ba_ = P.in[12][chn], bx_ = P.in[14][chn], sp = softplusf(-P.in[15][chn]);
#pragma unroll
        for (int r = 0; r < 16; ++r) { const int l = 32 * mi + crow(r, hi);
            const float rg = sigmoidf(accA[r] + ba_), ig = sigmoidf(accX[r] + bx_);
            const float la = -8.0f * rg * sp; const float a = expf(la); const float mult = sqrtf(fmaxf(-expm1f(2.f * la), 0.f));
            const float xl = bf2f(*(const u16*)(Xs + l * 144 + j * 2));
            af[l * 64 + j] = a; uf[l * 64 + j] = mult * (ig * xl); }
    }
    __syncthreads();
    const int j = tid & 63, seg = tid >> 6, chn = h * 64 + j;
    float Pp = 1.f, hl = 0.f;
#pragma unroll
    for (int i = 0; i < 16; ++i) { const int l = seg * 16 + i; const float a = af[l * 64 + j]; hl = a * hl + uf[l * 64 + j]; Pp *= a;
        if (PHASE_C) { uf[l * 64 + j] = hl; af[l * 64 + j] = Pp; } }
    segA[seg * 64 + j] = Pp; segH[seg * 64 + j] = hl;
    __syncthreads();
    float cin = PHASE_C ? ((const float*)(P.ws + WS_LCH))[(size_t)(b * 64 + c) * 1024 + chn] : 0.f;
    float At = 1.f;
    for (int s = 0; s < seg; ++s) { const float a = segA[s * 64 + j]; cin = a * cin + segH[s * 64 + j]; At *= a; }
    if (!PHASE_C) {
        if (seg == 7) { ((float*)(P.ws + WS_LCA))[(size_t)(b * 64 + c) * 1024 + chn] = At * Pp; ((float*)(P.ws + WS_LCH))[(size_t)(b * 64 + c) * 1024 + chn] = Pp * cin + hl; }
    } else {
#pragma unroll
        for (int i = 0; i < 16; ++i) { const int l = seg * 16 + i; const float hv = uf[l * 64 + j] + af[l * 64 + j] * cin;
            u16* gp = Y + (size_t)(tok0 + l) * ldy + chn; const float gt = bf2f(ZG[(size_t)(tok0 + l) * 2048 + 1024 + chn]);
            const float u_ = 0.7978845608028654f * (gt + 0.044715f * gt * gt * gt); const float th = 1.f - 2.f / (1.f + expf(2.f * u_));
            *gp = (u16)f2bf(hv * 0.5f * gt * (1.f + th)); }
    }
    __syncthreads();
}

__device__ __forceinline__ void scan_phase(const Params& P) {
    const int gtid = blockIdx.x * 512 + opaque_tid(), NT_ = gridDim.x * 512;
    float* st = P.out; const float* cdec = (const float*)(P.ws + WS_CDEC);
    for (int e2 = gtid; e2 < 2 * 16 * 4096; e2 += NT_) {
        const int bh = e2 >> 12, b = bh >> 4, h = bh & 15, off = (e2 & 4095) * 2;
        f32x2 prev = (f32x2){0.f, 0.f};
        for (int c0 = 0; c0 < 64; c0 += 8) {
            f32x2 tmp[8]; float dec[8];
#pragma unroll
            for (int q = 0; q < 8; ++q) { tmp[q] = *(const f32x2*)(st + ((size_t)(b * 64 + c0 + q) * 16 + h) * 8192 + off); dec[q] = cdec[(b * 64 + c0 + q) * 16 + h]; }
#pragma unroll
            for (int q = 0; q < 8; ++q) { *(f32x2*)(st + ((size_t)(b * 64 + c0 + q) * 16 + h) * 8192 + off) = prev; prev = prev * dec[q] + tmp[q]; }
        }
    }
    if (gtid < 2048) {
        const int b = gtid >> 10, chn = gtid & 1023; float hin = 0.f;
        const float* cA = (const float*)(P.ws + WS_LCA); float* cH = (float*)(P.ws + WS_LCH);
        for (int c0 = 0; c0 < 64; c0 += 8) {
            float A_[8], H_[8];
#pragma unroll
            for (int q = 0; q < 8; ++q) { A_[q] = cA[(size_t)(b * 64 + c0 + q) * 1024 + chn]; H_[q] = cH[(size_t)(b * 64 + c0 + q) * 1024 + chn]; }
#pragma unroll
            for (int q = 0; q < 8; ++q) { cH[(size_t)(b * 64 + c0 + q) * 1024 + chn] = hin; hin = A_[q] * hin + H_[q]; }
        }
    }
}

namespace att {
constexpr int KROW = 272, VROW = 136, KBYTES = 64 * KROW, VBYTES = 128 * VROW, BUF = KBYTES + VBYTES;
__device__ __forceinline__ void attn_unit(unsigned char* lds, const u16* QK, const u16* Vt, u16* O, const float* subln, float lam, int b, int h, int qb) {
    const int tid = opaque_tid(), lane = tid & 63, r32 = lane & 31, hi = lane >> 5, w = tid >> 6, qg = w >> 1, c = w & 1;
    const int q0 = qb * 128, qw = q0 + 32 * qg;
    const size_t rowbase = (size_t)b * SEQ;
    bf16x8 qf[4];
    { const u16* qp = QK + (rowbase + qw + r32) * 2048 + h * 128 + c * 64 + 8 * hi;
#pragma unroll
      for (int d0 = 0; d0 < 4; ++d0) qf[d0] = *(const bf16x8*)(qp + d0 * 16); }
    f32x16 o[4];
#pragma unroll
    for (int dt = 0; dt < 4; ++dt) o[dt] = zero16();
    float mrun = -1e30f, lrun = 0.f;
    const int NT = 2 * (qb + 1);
    const int krow = tid >> 4, kch = tid & 15, vrow = tid >> 3, vch = tid & 7;
    const u16* kg = QK + (rowbase + krow) * 2048 + 1024 + h * 128 + kch * 8;
    const u16* vg = Vt + (size_t)(h * 128 + vrow) * T + rowbase + vch * 8;
    u32x4 kr[2], vr[2];
#define ATT_LOAD(t) do { kr[0] = *(const u32x4*)(kg + (size_t)(t) * 64 * 2048); kr[1] = *(const u32x4*)(kg + (size_t)(t) * 64 * 2048 + 32 * 2048); \
                         vr[0] = *(const u32x4*)(vg + (size_t)(t) * 64); vr[1] = *(const u32x4*)(vg + (size_t)(t) * 64 + (size_t)64 * T); } while (0)
#define ATT_STORE(bufp) do { unsigned char* kb_ = (bufp); unsigned char* vb_ = kb_ + KBYTES; \
        *(u32x4*)(kb_ + krow * KROW + kch * 16) = kr[0]; *(u32x4*)(kb_ + (krow + 32) * KROW + kch * 16) = kr[1]; \
        *(u32x2*)(vb_ + vrow * VROW + vch * 16) = (u32x2){vr[0].x, vr[0].y}; *(u32x2*)(vb_ + vrow * VROW + vch * 16 + 8) = (u32x2){vr[0].z, vr[0].w}; \
        *(u32x2*)(vb_ + (vrow + 64) * VROW + vch * 16) = (u32x2){vr[1].x, vr[1].y}; *(u32x2*)(vb_ + (vrow + 64) * VROW + vch * 16 + 8) = (u32x2){vr[1].z, vr[1].w}; } while (0)
    ATT_LOAD(0); ATT_STORE(lds); __syncthreads();
    for (int t = 0; t < NT; ++t) {
        const unsigned char* kb = lds + (t & 1) * BUF; const unsigned char* vb = kb + KBYTES;
        if (t + 1 < NT) ATT_LOAD(t + 1);
        if (64 * t <= qw + 31) {
            bf16x8 pb[4];
            {
                f32x16 p0 = zero16(), p1 = zero16();
#pragma unroll
                for (int d0 = 0; d0 < 4; ++d0) {
                    const bf16x8 k0f = *(const bf16x8*)(kb + r32 * KROW + (c * 64 + d0 * 16 + 8 * hi) * 2);
                    const bf16x8 k1f = *(const bf16x8*)(kb + (32 + r32) * KROW + (c * 64 + d0 * 16 + 8 * hi) * 2);
                    p0 = mfma32(k0f, qf[d0], p0); p1 = mfma32(k1f, qf[d0], p1);
                }
                if (64 * t + 63 > qw) {
                    const int qgl = qw + r32;
#pragma unroll
                    for (int r = 0; r < 16; ++r) { const int kv = 64 * t + crow(r, hi); if (kv > qgl) p0[r] = -INFINITY; if (kv + 32 > qgl) p1[r] = -INFINITY; }
                }
                float mx = fmaxf(p0[0], p1[0]);
#pragma unroll
                for (int r = 1; r < 16; ++r) mx = fmaxf(mx, fmaxf(p0[r], p1[r]));
                mx = fmaxf(mx, __shfl_xor(mx, 32));
                const float mn = fmaxf(mrun, mx); const float f = __builtin_amdgcn_exp2f(mrun - mn); mrun = mn;
                float sum = 0.f;
#pragma unroll
                for (int r = 0; r < 16; ++r) { p0[r] = __builtin_amdgcn_exp2f(p0[r] - mn); p1[r] = __builtin_amdgcn_exp2f(p1[r] - mn); sum += p0[r] + p1[r]; }
                lrun = lrun * f + sum;
#pragma unroll
                for (int dt = 0; dt < 4; ++dt)
#pragma unroll
                    for (int r = 0; r < 16; ++r) o[dt][r] *= f;
#pragma unroll
                for (int s = 0; s < 2; ++s) {
                    u32x4 a, bq;
                    a.x = pk2(p0[8 * s + 0], p0[8 * s + 1]); a.y = pk2(p0[8 * s + 2], p0[8 * s + 3]); a.z = pk2(p0[8 * s + 4], p0[8 * s + 5]); a.w = pk2(p0[8 * s + 6], p0[8 * s + 7]);
                    bq.x = pk2(p1[8 * s + 0], p1[8 * s + 1]); bq.y = pk2(p1[8 * s + 2], p1[8 * s + 3]); bq.z = pk2(p1[8 * s + 4], p1[8 * s + 5]); bq.w = pk2(p1[8 * s + 6], p1[8 * s + 7]);
                    pb[s] = __builtin_bit_cast(bf16x8, a); pb[2 + s] = __builtin_bit_cast(bf16x8, bq);
                }
            }
#pragma unroll
            for (int dt = 0; dt < 4; ++dt)
#pragma unroll
                for (int s = 0; s < 4; ++s) {
                    const unsigned char* ap = vb + (32 * dt + r32) * VROW + (16 * s + 4 * hi) * 2;
                    const u32x2 lo = *(const u32x2*)ap, hi2 = *(const u32x2*)(ap + 16);
                    const bf16x8 vf = __builtin_bit_cast(bf16x8, (u32x4){lo.x, lo.y, hi2.x, hi2.y});
                    o[dt] = mfma32(vf, pb[s], o[dt]);
                }
        }
        if (t + 1 < NT) ATT_STORE(lds + ((t + 1) & 1) * BUF);
        __syncthreads();
    }
#undef ATT_LOAD
#undef ATT_STORE
    const float lt = lrun + __shfl_xor(lrun, 32);
    float* xb = (float*)lds + qg * 4096;
    if (c == 1) { const float inv = lam / lt;
#pragma unroll
        for (int dt = 0; dt < 4; ++dt)
#pragma unroll
            for (int r = 0; r < 16; ++r) xb[(32 * dt + crow(r, hi)) * 32 + r32] = o[dt][r] * inv; }
    __syncthreads();
    if (c == 0) {
        const float inv = 1.f / lt; float ssq = 0.f;
#pragma unroll
        for (int dt = 0; dt < 4; ++dt)
#pragma unroll
            for (int r = 0; r < 16; ++r) { const float v = o[dt][r] * inv - xb[(32 * dt + crow(r, hi)) * 32 + r32]; o[dt][r] = v; ssq += v * v; }
        ssq += __shfl_xor(ssq, 32);
        const float rstd = (1.f - LAMBDA_INIT) / sqrtf(ssq * (1.f / 128.f) + LN_EPS);
        u16* op = O + (rowbase + qw + r32) * 1024 + h * 128;
#pragma unroll
        for (int dt = 0; dt < 4; ++dt)
#pragma unroll
            for (int g4 = 0; g4 < 4; ++g4) { const int d = 32 * dt + 8 * g4 + 4 * hi; const f32x4 sw = *(const f32x4*)(subln + d);
                u32x2 wv; wv.x = pk2(o[dt][4 * g4 + 0] * rstd * sw.x, o[dt][4 * g4 + 1] * rstd * sw.y); wv.y = pk2(o[dt][4 * g4 + 2] * rstd * sw.z, o[dt][4 * g4 + 3] * rstd * sw.w);
                *(u32x2*)(op + d) = wv; }
    }
    __syncthreads();
}
}

__device__ __forceinline__ void attn_phase(const Params& P, unsigned char* lds) {
    float s1 = 0.f, s2 = 0.f;
    for (int i = 0; i < 64; ++i) { s1 += P.in[18][i] * P.in[19][i]; s2 += P.in[20][i] * P.in[21][i]; }
    const float lam = expf(s1) - expf(s2) + LAMBDA_INIT;
    const u16* QK = (const u16*)(P.ws + WS_QK); const u16* Vt = (const u16*)(P.ws + WS_VT); u16* O = (u16*)(P.ws + WS_O);
    for (int p = blockIdx.x; p < 512; p += gridDim.x) {
        const int bh = p >> 5, s = p & 31, b = bh >> 3, h = bh & 7;
        att::attn_unit(lds, QK, Vt, O, P.in[22], lam, b, h, 63 - s);
        att::attn_unit(lds, QK, Vt, O, P.in[22], lam, b, h, s);
    }
}

#define LAS __attribute__((address_space(3)))
#define XB_TMO      128
#define XB_XCNT(j)  (256  + 64 * (j))
#define XB_XSUB(j)  (1280 + 64 * (j))
#define XB_XGEN(j)  (2304 + 64 * (j))
#define XB_TOP      3328
#define XB_TOPGEN   3392
#define XCD_BAR_WORDS 3456
#define XB_SPIN_CAP (1u << 18)

__device__ __forceinline__ unsigned xb_ld(unsigned* p)              { return __hip_atomic_load(p, __ATOMIC_RELAXED, __HIP_MEMORY_SCOPE_AGENT); }
__device__ __forceinline__ unsigned xb_add(unsigned* p, unsigned v) { return __hip_atomic_fetch_add(p, v, __ATOMIC_RELAXED, __HIP_MEMORY_SCOPE_AGENT); }
__device__ __forceinline__ unsigned xb_xcc_id() { return (unsigned)__builtin_amdgcn_s_getreg((3 << 11) | 20) & 0xFu; }
#define XB_SPIN(cond, bar) do { unsigned _sp = 0; while (cond) { __builtin_amdgcn_s_sleep(1); \
    if ((++_sp & 255u) == 0u) { if (xb_ld(&(bar)[XB_TMO])) break; if (_sp > XB_SPIN_CAP) { atomicAdd(&(bar)[XB_TMO], 1u); break; } } } } while (0)

struct XcdBarrier {
    unsigned* bar; unsigned x;
    volatile LAS unsigned* st;
};

__device__ __forceinline__ XcdBarrier xcd_barrier_post(unsigned* bar, volatile LAS unsigned* st) {
    XcdBarrier b; b.bar = bar; b.x = xb_xcc_id(); b.st = st;
    if (threadIdx.x == 0) (void)xb_add(&bar[XB_XCNT(b.x)], 1u);
    return b;
}
__device__ __forceinline__ void xcd_barrier_complete(unsigned* bar, unsigned x, unsigned& nloc, unsigned& nx) {
    const unsigned G = gridDim.x * gridDim.y * gridDim.z;
    unsigned sum, cnt, mine, sp = 0u;
    for (;;) {
        sum = 0u; cnt = 0u; mine = 0u;
#pragma unroll
        for (unsigned j = 0; j < 16; ++j) { const unsigned c = xb_ld(&bar[XB_XCNT(j)]); sum += c; cnt += (c > 0u) ? 1u : 0u; mine = (j == x) ? c : mine; }
        if (sum == G) break;
        __builtin_amdgcn_s_sleep(1);
        if ((++sp & 255u) == 0u) { if (xb_ld(&bar[XB_TMO])) break; if (sp > XB_SPIN_CAP) { atomicAdd(&bar[XB_TMO], 1u); break; } }
    }
    nloc = mine > 0u ? mine : 1u; nx = cnt > 0u ? cnt : 1u;
}

__device__ __forceinline__ void xcd_barrier(const XcdBarrier& b) {
    asm volatile("s_waitcnt vmcnt(0)" ::: "memory");
    __syncthreads();
    if (threadIdx.x == 0) {
        unsigned* bar = b.bar;
        __builtin_amdgcn_s_waitcnt(0);
        unsigned nloc = b.st[0], nx = b.st[1];
        if (nloc == 0u) { xcd_barrier_complete(bar, b.x, nloc, nx); b.st[0] = nloc; b.st[1] = nx; }
        const unsigned old = xb_add(&bar[XB_XSUB(b.x)], 1u);
        const unsigned gen = old / nloc;
        if (old + 1u == (gen + 1u) * nloc) {
            __builtin_amdgcn_fence(__ATOMIC_RELEASE, "agent");
            asm volatile("s_waitcnt vmcnt(0)" ::: "memory");
            const unsigned og = xb_add(&bar[XB_TOP], 1u);
            const unsigned tg = og / nx;
            if (og + 1u == (tg + 1u) * nx) xb_add(&bar[XB_TOPGEN], 1u);
            else XB_SPIN(xb_ld(&bar[XB_TOPGEN]) == tg, bar);
            __builtin_amdgcn_fence(__ATOMIC_ACQUIRE, "agent");
            xb_add(&bar[XB_XGEN(b.x)], 1u);
            asm volatile("s_waitcnt vmcnt(0)" ::: "memory");
        } else {
            XB_SPIN(xb_ld(&bar[XB_XGEN(b.x)]) == gen, bar);
            __builtin_amdgcn_fence(__ATOMIC_ACQUIRE, "agent");
            asm volatile("s_waitcnt vmcnt(0)" ::: "memory");
        }
    }
    __syncthreads();
}

__global__ void __launch_bounds__(512) hybrid_fwd(Params P) {
    extern __shared__ __attribute__((aligned(16))) unsigned char lds[];
    cg::grid_group grid = cg::this_grid();
    unsigned char* ws = P.ws;
    const int G = gridDim.x, bx = blockIdx.x;
    u16* XB = (u16*)(ws + WS_XB); u16* ZG = (u16*)(ws + WS_ZG); u16* HB = (u16*)(ws + WS_H);

#ifndef PHM
#define PHM 0xffff
#endif
#ifndef DBLM
#define DBLM 0
#endif
#define PH(n) for (int rep_ = 0; rep_ < (((DBLM) >> (n)) & 1) + 1; ++rep_) if (PHM & (1 << (n)))
    unsigned* barw = (unsigned*)(ws + WS_BAR);
    volatile LAS unsigned* MISC = (volatile LAS unsigned*)((LAS unsigned char*)lds + MISC_OFF);
    if (threadIdx.x < 2) MISC[threadIdx.x] = 0u;
    __syncthreads();
    PH(0) prologue(P, lds);
    grid.sync();
    XcdBarrier xbar = xcd_barrier_post(barw, MISC);
#define GSYNC() xcd_barrier(xbar)
    PH(1) { Epi<0> E{ZG, (u16*)(ws + WS_XBC), (u16*)(ws + WS_XL), (float*)(ws + WS_DT), nullptr, 0};
      run_gemm<0>(lds, XB, (const u16*)(ws + WS_WIN), T, NIN, D, E); }
    GSYNC();
    PH(2) for (int u = bx; u < 256; u += G) ssd_A_unit(P, lds, u >> 7, (u >> 1) & 63, u & 1);
    PH(3) for (int u = bx; u < 2048; u += G) lru_unit<false>(P, lds, u >> 10, (u >> 4) & 63, u & 15, nullptr, 0);
    GSYNC();
#ifdef PROBE_SYNC
    for (int i_ = 0; i_ < 10; ++i_) GSYNC();
#endif
#ifdef PROBE_SCAN
    if (0)
#endif
    PH(4) scan_phase(P);
    GSYNC();
#ifdef PROBE_SSDC
    for (int u = bx; u < 256; u += G) ssd_C_unit(P, lds, u >> 7, (u >> 1) & 63, u & 1, XB, 1024);
#endif
#ifdef PROBE_LRUC
    for (int u = bx; u < 2048; u += G) lru_unit<true>(P, lds, u >> 10, (u >> 4) & 63, u & 15, XB, 1024);
#endif
    PH(5) for (int u = bx; u < 256; u += G) ssd_C_unit(P, lds, u >> 7, (u >> 1) & 63, u & 1, ZG, 2048);
    PH(6) for (int u = bx; u < 2048; u += G) lru_unit<true>(P, lds, u >> 10, (u >> 4) & 63, u & 15, ZG + 1024, 2048);
    GSYNC();
    PH(7) { Epi<1> E{nullptr, nullptr, nullptr, P.out, P.in[0], 0};
      run_gemm<1>(lds, ZG, (const u16*)(ws + WS_WOUT), T, D, 2048, E); }
    GSYNC();
    PH(8) ln_phase(P.out, P.in[24], P.in[25], P.out, XB);
    GSYNC();
    PH(9) { Epi<2> E{HB, nullptr, nullptr, nullptr, nullptr, FF};
      run_gemm<2>(lds, XB, (const u16*)(ws + WS_W1), T, FF, D, E); }
    GSYNC();
    { Epi<1> E{nullptr, nullptr, nullptr, P.out, P.out, 0};
      run_gemm<1>(lds, HB, (const u16*)(ws + WS_W2), T, D, FF, E); }
    GSYNC();
    ln_phase(P.out, P.in[28], P.in[29], P.out, XB);
    GSYNC();
    PH(10) { Epi<3> E{(u16*)(ws + WS_QK), nullptr, nullptr, nullptr, (const float*)(ws + WS_ROPE), 0};
      run_gemm<3>(lds, XB, (const u16*)(ws + WS_WQKV), T, 2048, D, E); }
    PH(11) { Epi<4> E{(u16*)(ws + WS_VT), nullptr, nullptr, nullptr, nullptr, T};
      run_gemm<4>(lds, (const u16*)(ws + WS_WQKV) + (size_t)2048 * D, XB, D, T, D, E); }
    GSYNC();
    PH(12) attn_phase(P, lds);
    GSYNC();
    { Epi<1> E{nullptr, nullptr, nullptr, P.out, P.out, 0};
      run_gemm<1>(lds, (const u16*)(ws + WS_O), (const u16*)(ws + WS_WAO), T, D, D, E); }
    GSYNC();
    ln_phase(P.out, P.in[24] + D, P.in[25] + D, P.out, XB);
    GSYNC();
    { Epi<2> E{HB, nullptr, nullptr, nullptr, nullptr, FF};
      run_gemm<2>(lds, XB, (const u16*)(ws + WS_W1) + (size_t)FF * D, T, FF, D, E); }
    GSYNC();
    { Epi<1> E{nullptr, nullptr, nullptr, P.out, P.out, 0};
      run_gemm<1>(lds, HB, (const u16*)(ws + WS_W2) + (size_t)FF * D, T, D, FF, E); }
    GSYNC();
    ln_phase(P.out, P.in[28] + D, P.in[29] + D, P.out, nullptr);
}

extern "C" void kernel_launch(void* const* d_in, const int* in_sizes, int n_in, void* d_out, int out_size, void* d_ws, size_t ws_size, hipStream_t stream) {
    static int grid = 0;
    if (grid == 0) {
        if (n_in != 30 || in_sizes[0] != T * D || out_size != T * D || ws_size < WS_END) { fprintf(stderr, "kernel_launch: unexpected shapes (n_in %d in0 %d out %d ws %zu)\n", n_in, n_in > 0 ? in_sizes[0] : -1, out_size, ws_size); grid = -1; return; }
        int dev = 0, cus = 0, per_cu = 0;
        hipGetDevice(&dev); hipDeviceGetAttribute(&cus, hipDeviceAttributeMultiprocessorCount, dev);
        hipFuncSetAttribute((const void*)hybrid_fwd, hipFuncAttributeMaxDynamicSharedMemorySize, LDS_BYTES);
        hipOccupancyMaxActiveBlocksPerMultiprocessor(&per_cu, (const void*)hybrid_fwd, 512, LDS_BYTES);
        if (per_cu < 1) { fprintf(stderr, "kernel_launch: occupancy query says %d blocks per CU\n", per_cu); per_cu = 1; }
        (void)hipGetLastError();
        grid = cus;
    }
    if (grid < 0) return;
    if (hipMemsetAsync((char*)d_ws + WS_BAR, 0, 16384, stream) != hipSuccess) { fprintf(stderr, "kernel_launch: memset of the barrier words failed\n"); return; }
    Params p{};
    for (int i = 0; i < 30; ++i) p.in[i] = (const float*)d_in[i];
    p.out = (float*)d_out; p.ws = (unsigned char*)d_ws;
    void* args[] = {&p};
    hipError_t e = hipLaunchCooperativeKernel((const void*)hybrid_fwd, dim3(grid), dim3(512), args, LDS_BYTES, stream);
    if (e != hipSuccess) fprintf(stderr, "cooperative launch failed: %s (grid %d)\n", hipGetErrorString(e), grid);
}
```

```cpp
#include <hip/hip_runtime.h>
#include <hip/hip_cooperative_groups.h>
#include <cstdio>
#include <cstdint>
#include <cmath>
namespace cg = cooperative_groups;
namespace pg8 {
#define PG8_LAS __attribute__((address_space(3)))
typedef unsigned short bf16_t;
typedef short bf16x8 __attribute__((ext_vector_type(8)));
typedef float f32x4 __attribute__((ext_vector_type(4)));
typedef unsigned u32x4 __attribute__((ext_vector_type(4)));
constexpr int BM = 256, BK = 64, HALF = 128, HTB = HALF * BK * 2  , STAGE_BYTES = 8 * HTB, NXCD = 8, WGM = 8;

__host__ __device__ __forceinline__ int lds_byte(int r, int c) { const int st = (r >> 4) * 2 + (c >> 5), rr = r & 15, cc = c & 31, ob = rr * 64 + cc * 2; return st * 1024 + (ob ^ (((ob >> 9) & 1) << 5)); }
__host__ __device__ __forceinline__ void stage_rc(int b, int& R, int& C) { const int st = b / 1024, sb = b % 1024, swz = sb ^ (((sb >> 9) & 1) << 5); R = (st >> 1) * 16 + swz / 64; C = (st & 1) * 32 + (swz % 64) / 2; }
__host__ __device__ __forceinline__ int perm32(int rho) { const int n = rho >> 4, i = rho & 15; return 8 * (i >> 2) + 4 * n + (i & 3); }

struct Unit { int pm, pn; };
struct Gemm { const bf16_t* A; const bf16_t* Bt; int M, N, K; };

struct StaticOrder {
    int nM, nN, nwg, G, c;
    __host__ __device__ void init(int M, int N, int G_, int c_) { nM = M / BM; nN = N / BM; nwg = nM * nN; G = G_; c = c_; }
    __host__ __device__ bool next(int i, Unit& u) const {
        const long L = (long)i * G + c; if (L >= nwg) return false;
        int wgid = (int)L; { const int q = nwg / NXCD, r = nwg % NXCD, xcd = wgid % NXCD, off = wgid / NXCD; wgid = (xcd < r ? xcd * (q + 1) : r * (q + 1) + (xcd - r) * q) + off; }
        const int nig = WGM * nN, gid = wgid / nig, fm = gid * WGM, gsz = (nM - fm) < WGM ? (nM - fm) : WGM;
        u.pm = fm + ((wgid % nig) % gsz); u.pn = (wgid % nig) / gsz; return true;
    }
    __device__ __forceinline__ void a_ready(const Unit&) const {}
    __device__ __forceinline__ void done(const Unit&) const {}
};

__device__ __forceinline__ unsigned cvt_pk_bf16(float lo, float hi) { unsigned r; asm volatile("v_cvt_pk_bf16_f32 %0, %1, %2" : "=v"(r) : "v"(lo), "v"(hi)); return r; }
typedef float f32x2 __attribute__((ext_vector_type(2)));
template <class Epi, class Sched, bool ALIGN_EPI = false, bool SP2 = false>
__device__ __forceinline__ void gemm_phase(PG8_LAS unsigned char* lds, const Gemm g, const Sched& S, const Epi& E) {
    int tid_o = threadIdx.x; asm volatile("" : "+v"(tid_o));
    const int tid = tid_o, wid = __builtin_amdgcn_readfirstlane(tid >> 6), lane = tid & 63, wr = wid >> 2, wc = wid & 3, fr = lane & 15, fq = lane >> 4;
    const int K = g.K, nt = K / BK;
    unsigned voffA[2], voffB[2];
#pragma unroll
    for (int i = 0; i < 2; ++i) { int R, C; stage_rc(tid * 16 + i * 8192, R, C); const int Rb = Epi::PERM ? ((R & ~31) + perm32(R & 31)) : R;
        voffA[i] = (unsigned)(R * K + C) * 2u; voffB[i] = (unsigned)(Rb * K + C) * 2u; }
    const size_t kstep = (size_t)(BK * 2);
    const size_t hstep = (size_t)HALF * K * 2;
    const size_t tstep = 2 * hstep;
    const unsigned ldsw = (unsigned)wid * 1024u;
    const int aoff = lds_byte(wr * 64 + fr, fq * 8), boff = lds_byte(wc * 32 + fr, fq * 8);
#define PG8_SA(b, h) (((b) * 2 + (h)) * HTB)
#define PG8_SB(b, h) ((4 + (b) * 2 + (h)) * HTB)
#define PG8_STAGE(bufoff, gbase, voff) do { _Pragma("unroll") for (int _i = 0; _i < 2; ++_i) \
        __builtin_amdgcn_global_load_lds((const unsigned*)((const char*)(gbase) + (voff)[_i]), (PG8_LAS unsigned*)(lds + (bufoff) + ldsw + _i * 8192), 16, 0, 0); } while (0)
#define PG8_LDA(dst, b, h) do { _Pragma("unroll") for (int m = 0; m < 4; ++m) _Pragma("unroll") for (int k = 0; k < 2; ++k) dst[m][k] = *(const PG8_LAS bf16x8*)(lds + PG8_SA(b, h) + aoff + m * 2048 + k * 1024); } while (0)
#define PG8_LDB(dst, b, h) do { _Pragma("unroll") for (int n = 0; n < 2; ++n) _Pragma("unroll") for (int k = 0; k < 2; ++k) dst[n][k] = *(const PG8_LAS bf16x8*)(lds + PG8_SB(b, h) + boff + n * 2048 + k * 1024); } while (0)
#define PG8_MMA(ai, bj, At, Bt) do { __builtin_amdgcn_s_setprio(1); _Pragma("unroll") for (int m = 0; m < 4; ++m) _Pragma("unroll") for (int n = 0; n < 2; ++n) _Pragma("unroll") for (int k = 0; k < 2; ++k) \
        acc[ai][bj][m][n] = __builtin_amdgcn_mfma_f32_16x16x32_bf16(Bt[n][k], At[m][k], acc[ai][bj][m][n], 0, 0, 0); __builtin_amdgcn_s_setprio(0); } while (0)
#define PG8_WAIT_V(n) asm volatile("s_waitcnt vmcnt(" #n ")" ::: "memory")
#define PG8_WAIT_L(n) asm volatile("s_waitcnt lgkmcnt(" #n ")" ::: "memory")
#define PG8_BAR __builtin_amdgcn_s_barrier()
#define PG8_SCHED __builtin_amdgcn_sched_barrier(0)
    Unit cur, nxt; int ui = 0;
    if (!S.next(0, cur)) return;
    f32x4 acc[2][2][4][2];
#pragma unroll
    for (int a = 0; a < 2; ++a)
#pragma unroll
        for (int b = 0; b < 2; ++b)
#pragma unroll
            for (int m = 0; m < 4; ++m)
#pragma unroll
                for (int n = 0; n < 2; ++n) acc[a][b][m][n] = (f32x4){0.f, 0.f, 0.f, 0.f};
    bf16x8 At[4][2], B0[2][2], B1[2][2];
    const char* cA = (const char*)g.A + (size_t)cur.pm * tstep; const char* cB = (const char*)g.Bt + (size_t)cur.pn * tstep;
    S.a_ready(cur);
    if constexpr (SP2) {
        PG8_STAGE(PG8_SB(0, 0), cB, voffB); PG8_STAGE(PG8_SB(0, 1), cB + hstep, voffB); PG8_STAGE(PG8_SA(0, 0), cA, voffA); PG8_STAGE(PG8_SA(0, 1), cA + hstep, voffA);
        if (wr == 1) PG8_BAR;
        PG8_WAIT_V(2); PG8_BAR;
        PG8_STAGE(PG8_SB(1, 0), cB + kstep, voffB); PG8_STAGE(PG8_SA(1, 0), cA + kstep, voffA); PG8_STAGE(PG8_SB(1, 1), cB + hstep + kstep, voffB);
        PG8_WAIT_V(6); PG8_BAR;
    } else {
        PG8_STAGE(PG8_SB(0, 0), cB, voffB); PG8_STAGE(PG8_SA(0, 0), cA, voffA); PG8_STAGE(PG8_SB(0, 1), cB + hstep, voffB); PG8_STAGE(PG8_SA(0, 1), cA + hstep, voffA);
        if (wr == 1) PG8_BAR;
        PG8_WAIT_V(4); PG8_BAR;
        PG8_STAGE(PG8_SB(1, 0), cB + kstep, voffB); PG8_STAGE(PG8_SA(1, 0), cA + kstep, voffA); PG8_STAGE(PG8_SB(1, 1), cB + hstep + kstep, voffB);
        PG8_WAIT_V(6); PG8_BAR;
    }
    for (;;) {
        const bool has_next = S.next(ui + 1, nxt);
        const char* nA = has_next ? (const char*)g.A + (size_t)nxt.pm * tstep : cA; const char* nB = has_next ? (const char*)g.Bt + (size_t)nxt.pn * tstep : cB;
        for (int t = 0; t < nt; t += 2) {
            const bool last = (t == nt - 2);
            const char* a1 = cA + (size_t)(t + 1) * kstep;
            const char* a2 = last ? nA : cA + (size_t)(t + 2) * kstep; const char* b2 = last ? nB : cB + (size_t)(t + 2) * kstep;
            const char* a3 = a2 + kstep; const char* b3 = b2 + kstep;
            if (last && has_next) S.a_ready(nxt);
            if constexpr (SP2) {
            PG8_LDB(B0, 0, 0); PG8_LDB(B1, 0, 1); PG8_SCHED; PG8_LDA(At, 0, 0); PG8_STAGE(PG8_SA(1, 1), a1 + hstep, voffA);
            PG8_WAIT_V(8); PG8_WAIT_L(0); PG8_BAR; PG8_MMA(0, 0, At, B0); PG8_MMA(0, 1, At, B1); PG8_BAR; PG8_SCHED;
            PG8_LDA(At, 0, 1); PG8_STAGE(PG8_SB(0, 0), b2, voffB); PG8_STAGE(PG8_SB(0, 1), b2 + hstep, voffB); PG8_STAGE(PG8_SA(0, 0), a2, voffA);
            PG8_WAIT_V(8); PG8_WAIT_L(0); PG8_BAR; PG8_MMA(1, 0, At, B0); PG8_MMA(1, 1, At, B1); PG8_BAR; PG8_SCHED;
            PG8_LDB(B0, 1, 0); PG8_LDB(B1, 1, 1); PG8_SCHED; PG8_LDA(At, 1, 0); PG8_STAGE(PG8_SA(0, 1), a2 + hstep, voffA);
            PG8_WAIT_V(8); PG8_WAIT_L(0); PG8_BAR; PG8_MMA(0, 0, At, B0); PG8_MMA(0, 1, At, B1); PG8_BAR; PG8_SCHED;
            PG8_LDA(At, 1, 1); PG8_STAGE(PG8_SB(1, 0), b3, voffB); PG8_STAGE(PG8_SB(1, 1), b3 + hstep, voffB); PG8_STAGE(PG8_SA(1, 0), a3, voffA);
            PG8_WAIT_V(8); PG8_WAIT_L(0); PG8_BAR; PG8_MMA(1, 0, At, B0); PG8_MMA(1, 1, At, B1); PG8_BAR; PG8_SCHED;
            } else {
            PG8_LDB(B0, 0, 0); PG8_SCHED; PG8_LDA(At, 0, 0); PG8_STAGE(PG8_SA(1, 1), a1 + hstep, voffA);
            PG8_WAIT_L(8); PG8_BAR; PG8_WAIT_L(0); PG8_MMA(0, 0, At, B0); PG8_BAR; PG8_SCHED;
            PG8_LDB(B1, 0, 1); PG8_STAGE(PG8_SB(0, 0), b2, voffB);
            PG8_BAR; PG8_WAIT_L(0); PG8_MMA(0, 1, At, B1); PG8_BAR;
            PG8_LDA(At, 0, 1); PG8_STAGE(PG8_SA(0, 0), a2, voffA);
            PG8_BAR; PG8_WAIT_L(0); PG8_MMA(1, 0, At, B0); PG8_BAR; PG8_SCHED;
            PG8_STAGE(PG8_SB(0, 1), b2 + hstep, voffB);
            PG8_WAIT_V(6); PG8_BAR; PG8_MMA(1, 1, At, B1); PG8_BAR;
            PG8_LDB(B0, 1, 0); PG8_SCHED; PG8_LDA(At, 1, 0); PG8_STAGE(PG8_SA(0, 1), a2 + hstep, voffA);
            PG8_WAIT_L(8); PG8_BAR; PG8_WAIT_L(0); PG8_MMA(0, 0, At, B0); PG8_BAR; PG8_SCHED;
            PG8_LDB(B1, 1, 1); PG8_STAGE(PG8_SB(1, 0), b3, voffB);
            PG8_BAR; PG8_WAIT_L(0); PG8_MMA(0, 1, At, B1); PG8_BAR;
            PG8_LDA(At, 1, 1); PG8_STAGE(PG8_SA(1, 0), a3, voffA);
            PG8_BAR; PG8_WAIT_L(0); PG8_MMA(1, 0, At, B0); PG8_BAR; PG8_SCHED;
            PG8_STAGE(PG8_SB(1, 1), b3 + hstep, voffB);
            PG8_WAIT_V(6); PG8_BAR; PG8_MMA(1, 1, At, B1); PG8_BAR;
            }
        }
        if constexpr (ALIGN_EPI) { if (wr == 0) PG8_BAR; }
        if constexpr (!Epi::AFTER_DRAIN) { E(acc, cur, wr, wc, fr, fq); S.done(cur); }
        if (!has_next) break;
#pragma unroll
        for (int a = 0; a < 2; ++a)
#pragma unroll
            for (int b = 0; b < 2; ++b)
#pragma unroll
                for (int m = 0; m < 4; ++m)
#pragma unroll
                    for (int n = 0; n < 2; ++n) acc[a][b][m][n] = (f32x4){0.f, 0.f, 0.f, 0.f};
        cur = nxt; cA = nA; cB = nB; ++ui;
        if constexpr (ALIGN_EPI) { if (wr == 1) PG8_BAR; }
    }
    PG8_WAIT_V(0);
    if constexpr (!ALIGN_EPI) { if (wr == 0) PG8_BAR; }
    PG8_BAR;
    if constexpr (Epi::AFTER_DRAIN) { E.fused(acc, cur, wr, wc, fr, fq, lds, wid, lane); S.done(cur); }
#undef PG8_SA
#undef PG8_SB
#undef PG8_STAGE
#undef PG8_LDA
#undef PG8_LDB
#undef PG8_MMA
#undef PG8_WAIT_V
#undef PG8_WAIT_L
#undef PG8_BAR
#undef PG8_SCHED
}
}

typedef unsigned short u16;
typedef short bf16x8 __attribute__((ext_vector_type(8)));
typedef short bf16x4 __attribute__((ext_vector_type(4)));
typedef float f32x4 __attribute__((ext_vector_type(4)));
typedef float f32x2 __attribute__((ext_vector_type(2)));
typedef float f32x16 __attribute__((ext_vector_type(16)));
typedef unsigned u32x4 __attribute__((ext_vector_type(4)));
typedef unsigned u32x2 __attribute__((ext_vector_type(2)));

constexpr int SEQ = 8192, NB = 2, T = NB * SEQ, D = 1024, FF = 4096;
constexpr int NIN = 4864;
constexpr int IN_COLS = 4624;
constexpr float ALPHA = 1.41421356237f, LN_EPS = 1e-5f;
constexpr float LAMBDA_INIT = 0.35550906759f;
constexpr float QSCALE = 0.125f * 1.4426950408889634f;
constexpr size_t MiB = 1u << 20;
constexpr size_t WS_WIN = 0;
constexpr size_t WS_WOUT = WS_WIN + (size_t)NIN * D * 2;
constexpr size_t WS_W1 = WS_WOUT + (size_t)D * 2048 * 2;
constexpr size_t WS_W2 = WS_W1 + 2 * (size_t)FF * D * 2;
constexpr size_t WS_WQKV = WS_W2 + 2 * (size_t)FF * D * 2;
constexpr size_t WS_WAO = WS_WQKV + (size_t)3072 * D * 2;
constexpr size_t WS_WEND = WS_WAO + (size_t)D * D * 2;
static_assert(WS_WEND <= 54 * MiB, "weights");
constexpr size_t WS_DT = 54 * MiB;
constexpr size_t WS_ROPE = 55 * MiB;
constexpr size_t WS_CDEC = 56 * MiB;
constexpr size_t WS_LCA = 56 * MiB + 65536;
constexpr size_t WS_LCH = WS_LCA + 524288;
constexpr size_t WS_ZG = 58 * MiB;
constexpr size_t WS_XBC = 122 * MiB;
constexpr size_t WS_XL = 170 * MiB;
constexpr size_t WS_XB = 202 * MiB;
constexpr size_t WS_END = 234 * MiB;
constexpr size_t WS_H = 58 * MiB;
constexpr size_t WS_QK = 58 * MiB;
constexpr size_t WS_VT = 122 * MiB;
constexpr size_t WS_O = 154 * MiB;
constexpr size_t WS_BAR = 57 * MiB + 524288;
static_assert(WS_LCH + 524288 <= WS_BAR && WS_BAR + 16384 <= WS_ZG, "misc map");
constexpr int LDS_BYTES = 147456, MISC_OFF = 131072;

struct Params { const float* in[30]; float* out; unsigned char* ws; };

typedef __bf16 hwbf16x2 __attribute__((ext_vector_type(2)));
__device__ __forceinline__ unsigned pk2(float lo, float hi) { f32x2 v = {lo, hi}; return __builtin_bit_cast(unsigned, __builtin_convertvector(v, hwbf16x2)); }
__device__ __forceinline__ unsigned f2bf(float f) { return pk2(f, 0.f) & 0xffffu; }
__device__ __forceinline__ float bf2f(unsigned v) { return __builtin_bit_cast(float, v << 16); }
__device__ __forceinline__ float bflo(unsigned w) { return __builtin_bit_cast(float, w << 16); }
__device__ __forceinline__ float bfhi(unsigned w) { return __builtin_bit_cast(float, w & 0xffff0000u); }
__device__ __forceinline__ int crow(int r, int hi) { return (r & 3) + 8 * (r >> 2) + 4 * hi; }
__device__ __forceinline__ f32x16 mfma32(bf16x8 a, bf16x8 b, f32x16 c) { return __builtin_amdgcn_mfma_f32_32x32x16_bf16(a, b, c, 0, 0, 0); }
__device__ __forceinline__ float softplusf(float x) { return x > 20.f ? x : log1pf(expf(x)); }
__device__ __forceinline__ float frcp(float x) { return __builtin_amdgcn_rcpf(x); }
__device__ __forceinline__ float sigmoidf(float x) { return __builtin_amdgcn_rcpf(1.f + __builtin_amdgcn_exp2f(-1.4426950408889634f * x)); }
__device__ __forceinline__ float fexp(float x) { return __builtin_amdgcn_exp2f(x * 1.4426950408889634f); }
__device__ __forceinline__ int opaque_tid() { int t = threadIdx.x; asm volatile("" : "+v"(t)); return t; }
__device__ __forceinline__ f32x16 zero16() { f32x16 z; for (int i = 0; i < 16; ++i) z[i] = 0.f; return z; }

template <int MODE> struct Epi {
    static constexpr bool PERM = true, AFTER_DRAIN = false;
    u16* o0; u16* o1; u16* o2; float* f0; const float* base; int ldc;
    __device__ __forceinline__ void operator()(const pg8::f32x4 (&acc)[2][2][4][2], const pg8::Unit& u, int wr, int wc, int fr, int fq) const {
#pragma unroll
        for (int ai = 0; ai < 2; ++ai)
#pragma unroll
            for (int m = 0; m < 4; ++m) {
                const int row = u.pm * 256 + ai * 128 + wr * 64 + m * 16 + fr;
#pragma unroll
                for (int bj = 0; bj < 2; ++bj) {
                    const int col0 = u.pn * 256 + bj * 128 + wc * 32 + 8 * fq;
                    f32x4 v0 = acc[ai][bj][m][0], v1 = acc[ai][bj][m][1];
                    if (MODE == 0) {
                        u16* dst;
                        if (u.pn < 8) dst = o0 + (size_t)row * 2048 + col0;
                        else if (u.pn < 14) dst = o1 + (size_t)row * 1536 + (col0 - 2048);
                        else if (u.pn < 18) dst = o2 + (size_t)row * 1024 + (col0 - 3584);
                        else { if (col0 < 4624) { float* d = f0 + (size_t)row * 16 + (col0 - 4608); *(f32x4*)d = v0; *(f32x4*)(d + 4) = v1; } continue; }
                        u32x4 w; w.x = pk2(v0[0], v0[1]); w.y = pk2(v0[2], v0[3]); w.z = pk2(v1[0], v1[1]); w.w = pk2(v1[2], v1[3]);
                        *(u32x4*)dst = w;
                    } else if (MODE == 1) {
                        const float* bs = base + (size_t)row * 1024 + col0; float* o = f0 + (size_t)row * 1024 + col0;
                        const f32x4 b0 = *(const f32x4*)bs, b1 = *(const f32x4*)(bs + 4);
                        *(f32x4*)o = b0 * ALPHA + v0; *(f32x4*)(o + 4) = b1 * ALPHA + v1;
                    } else if (MODE == 2) {
#pragma unroll
                        for (int i = 0; i < 4; ++i) { float a = fmaxf(v0[i], 0.f), b = fmaxf(v1[i], 0.f); v0[i] = a * a; v1[i] = b * b; }
                        u32x4 w; w.x = pk2(v0[0], v0[1]); w.y = pk2(v0[2], v0[3]); w.z = pk2(v1[0], v1[1]); w.w = pk2(v1[2], v1[3]);
                        *(u32x4*)(o0 + (size_t)row * ldc + col0) = w;
                    } else if (MODE == 3) {
                        if ((wc & 1) == 0) {
                            f32x4 p0, p1;
#pragma unroll
                            for (int i = 0; i < 4; ++i) { p0[i] = __shfl_xor(v0[i], 16); p1[i] = __shfl_xor(v1[i], 16); }
                            if (fq < 2) {
                                const float* rp = base + (size_t)row * 16;
                                const f32x4 c0 = *(const f32x4*)rp, c1 = *(const f32x4*)(rp + 4), s0 = *(const f32x4*)(rp + 8), s1 = *(const f32x4*)(rp + 12);
                                if (fq == 0) { v0 = v0 * c0 - p0 * s0; v1 = v1 * c1 - p1 * s1; }
                                else { v0 = v0 * c0 + p0 * s0; v1 = v1 * c1 + p1 * s1; }
                            }
                        }
                        if (col0 < 1024) { v0 = v0 * QSCALE; v1 = v1 * QSCALE; }
                        u32x4 w; w.x = pk2(v0[0], v0[1]); w.y = pk2(v0[2], v0[3]); w.z = pk2(v1[0], v1[1]); w.w = pk2(v1[2], v1[3]);
                        *(u32x4*)(o0 + (size_t)row * 2048 + col0) = w;
                    } else {
                        u32x4 w; w.x = pk2(v0[0], v0[1]); w.y = pk2(v0[2], v0[3]); w.z = pk2(v1[0], v1[1]); w.w = pk2(v1[2], v1[3]);
                        *(u32x4*)(o0 + (size_t)row * ldc + col0) = w;
                    }
                }
            }
    }
};

template <int MODE> __device__ __forceinline__ void run_gemm(unsigned char* lds, const u16* A, const u16* Bt, int M, int N, int K, const Epi<MODE>& E) {
    pg8::Gemm g{A, Bt, M, N, K}; pg8::StaticOrder S; S.init(M, N, (int)gridDim.x, (int)blockIdx.x);
    pg8::gemm_phase<Epi<MODE>, pg8::StaticOrder, true, true>((PG8_LAS unsigned char*)lds, g, S, E);
    __syncthreads();
}

__device__ __forceinline__ int win_src_col(int n) {
    if (n < 1024) return n;
    if (n < 2048) return n - 1024 + 2576;
    if (n < 3584) return n - 2048 + 1024;
    if (n < 4608) return n - 3584 + 3600;
    if (n < 4624) return n - 4608 + 2560;
    return -1;
}
template <bool MAP> __device__ __forceinline__ void transpose_item(const float* W, int K, int Nsrc, int nblk, u16* WT, float* scr, int item, int lane) {
    const int kb = item / nblk, nb = item % nblk, k0 = 64 * kb, n0 = 32 * nb;
    const int nn = n0 + (lane & 31); const int sc = MAP ? win_src_col(nn) : nn;
#pragma unroll 8
    for (int i = 0; i < 32; ++i) { const int kk = 2 * i + (lane >> 5); scr[kk * 33 + (lane & 31)] = sc >= 0 ? W[(size_t)(k0 + kk) * Nsrc + sc] : 0.f; }
    __builtin_amdgcn_s_waitcnt(0xc07f); asm volatile("" ::: "memory");
    const int c = lane & 7;
#pragma unroll
    for (int j = 0; j < 4; ++j) { const int n = (lane >> 3) + 8 * j; const float* s = scr + (8 * c) * 33 + n;
        u32x4 o; o.x = pk2(s[0 * 33], s[1 * 33]); o.y = pk2(s[2 * 33], s[3 * 33]); o.z = pk2(s[4 * 33], s[5 * 33]); o.w = pk2(s[6 * 33], s[7 * 33]);
        *(u32x4*)(WT + (size_t)(n0 + n) * K + k0 + 8 * c) = o; }
    __builtin_amdgcn_s_waitcnt(0xc07f); asm volatile("" ::: "memory");
}
__device__ __forceinline__ float wave_sum(float v) {
#pragma unroll
    for (int o = 1; o < 64; o <<= 1) v += __shfl_xor(v, o);
    return v;
}
__device__ __forceinline__ void ln_phase(const float* v, const float* g, const float* bt, float* outf, u16* outb) {
    const int tid = opaque_tid(), lane = tid & 63, wave = tid >> 6;
    const int gw = blockIdx.x * 8 + wave, NGW = gridDim.x * 8;
    f32x4 gg[4], bb[4];
#pragma unroll
    for (int j = 0; j < 4; ++j) { gg[j] = *((const f32x4*)g + lane + 64 * j); bb[j] = *((const f32x4*)bt + lane + 64 * j); }
    for (int m = gw; m < T; m += NGW) {
        const f32x4* xr = (const f32x4*)(v + (size_t)m * D) + lane;
        f32x4 x[4]; float s = 0.f;
#pragma unroll
        for (int j = 0; j < 4; ++j) { x[j] = xr[64 * j]; s += (x[j].x + x[j].y) + (x[j].z + x[j].w); }
        const float mean = wave_sum(s) * (1.f / D); float s2 = 0.f;
#pragma unroll
        for (int j = 0; j < 4; ++j) { x[j] = x[j] - mean; s2 += (x[j].x * x[j].x + x[j].y * x[j].y) + (x[j].z * x[j].z + x[j].w * x[j].w); }
        const float rstd = 1.f / sqrtf(wave_sum(s2) * (1.f / D) + LN_EPS);
#pragma unroll
        for (int j = 0; j < 4; ++j) x[j] = x[j] * rstd * gg[j] + bb[j];
        if (outf) { f32x4* o = (f32x4*)(outf + (size_t)m * D) + lane;
#pragma unroll
            for (int j = 0; j < 4; ++j) o[64 * j] = x[j]; }
        if (outb) { u32x2* o = (u32x2*)(outb + (size_t)m * D) + lane;
#pragma unroll
            for (int j = 0; j < 4; ++j) { u32x2 w; w.x = pk2(x[j].x, x[j].y); w.y = pk2(x[j].z, x[j].w); o[64 * j] = w; } }
    }
}

__device__ __forceinline__ void prologue(const Params& P, unsigned char* lds) {
    const int tid = opaque_tid(), lane = tid & 63, wave = tid >> 6;
    float* scr = (float*)(lds + wave * 16384);
    const int gw = blockIdx.x * 8 + wave, NGW = gridDim.x * 8;
    unsigned char* ws = P.ws;
    constexpr int I_IN = (D / 64) * (NIN / 32), I_OUT = (2048 / 64) * (D / 32), I_1 = (D / 64) * (FF / 32), I_2 = (FF / 64) * (D / 32), I_QKV = (D / 64) * (3072 / 32), I_AO = (D / 64) * (D / 32);
    constexpr int NITEMS = I_IN + I_OUT + 2 * I_1 + 2 * I_2 + I_QKV + I_AO;
    for (int it = gw; it < NITEMS; it += NGW) {
        int r = it;
        if (r < I_IN) { transpose_item<true>(P.in[2], D, IN_COLS, NIN / 32, (u16*)(ws + WS_WIN), scr, r, lane); continue; } r -= I_IN;
        if (r < I_OUT) { transpose_item<false>(P.in[16], 2048, D, D / 32, (u16*)(ws + WS_WOUT), scr, r, lane); continue; } r -= I_OUT;
        if (r < I_1) { transpose_item<false>(P.in[26], D, FF, FF / 32, (u16*)(ws + WS_W1), scr, r, lane); continue; } r -= I_1;
        if (r < I_1) { transpose_item<false>(P.in[26] + (size_t)D * FF, D, FF, FF / 32, (u16*)(ws + WS_W1) + (size_t)FF * D, scr, r, lane); continue; } r -= I_1;
        if (r < I_2) { transpose_item<false>(P.in[27], FF, D, D / 32, (u16*)(ws + WS_W2), scr, r, lane); continue; } r -= I_2;
        if (r < I_2) { transpose_item<false>(P.in[27] + (size_t)D * FF, FF, D, D / 32, (u16*)(ws + WS_W2) + (size_t)FF * D, scr, r, lane); continue; } r -= I_2;
        if (r < I_QKV) { transpose_item<false>(P.in[17], D, 3072, 3072 / 32, (u16*)(ws + WS_WQKV), scr, r, lane); continue; } r -= I_QKV;
        transpose_item<false>(P.in[23], D, D, D / 32, (u16*)(ws + WS_WAO), scr, r, lane);
    }
    for (int m = gw; m < T; m += NGW) {
        const f32x4* xr = (const f32x4*)(P.in[0] + (size_t)m * D) + lane; u32x2* o = (u32x2*)((u16*)(ws + WS_XB) + (size_t)m * D) + lane;
#pragma unroll
        for (int j = 0; j < 4; ++j) { const f32x4 x = xr[64 * j]; u32x2 w; w.x = pk2(x.x, x.y); w.y = pk2(x.z, x.w); o[64 * j] = w; }
    }
    const int* pos = (const int*)P.in[1]; float* rope = (float*)(ws + WS_ROPE);
    for (int e = blockIdx.x * 512 + tid; e < T * 8; e += gridDim.x * 512) {
        const int tok = e >> 3, i = e & 7;
        const float inv = powf(500000.0f, -(float)i * 0.125f);
        const float ang = (float)pos[tok] * inv;
        rope[tok * 16 + i] = cosf(ang); rope[tok * 16 + 8 + i] = sinf(ang);
    }
}

template <int NCH, int ROWS, bool SILU, bool TRANS>
__device__ __forceinline__ void conv_tile(const u16* src, int ld, int col0, const float* cw, const float* cb, int cld, size_t tokbase, int t0,
                                          unsigned char* dst, int RS, const float* rowscale, int tid) {
    static_assert(NCH * (128 / ROWS) == 512, "all 512 threads work");
    const int ch = tid % NCH, rg = tid / NCH, c0 = col0 + ch * 8;
    u32x4 in[ROWS + 3];
#pragma unroll
    for (int i = 0; i < ROWS + 3; ++i) { const int tr = t0 + rg * ROWS - 3 + i;
        if (tr >= 0) in[i] = *(const u32x4*)(src + (tokbase + tr) * ld + c0); else in[i] = (u32x4){0u, 0u, 0u, 0u}; }
    float out[ROWS][8];
#pragma unroll
    for (int hf = 0; hf < 2; ++hf) {
        f32x4 w[4];
#pragma unroll
        for (int k = 0; k < 4; ++k) w[k] = *(const f32x4*)(cw + (size_t)k * cld + c0 + 4 * hf);
        const f32x4 bias = *(const f32x4*)(cb + c0 + 4 * hf);
#pragma unroll
        for (int j = 0; j < ROWS; ++j) {
            const float rs = rowscale ? rowscale[rg * ROWS + j] : 1.f;
#pragma unroll
            for (int e = 0; e < 4; ++e) {
                float a = bias[e];
#pragma unroll
                for (int k = 0; k < 4; ++k) { const unsigned wd = in[j + k][2 * hf + (e >> 1)]; const float xv = (e & 1) ? bfhi(wd) : bflo(wd); a += w[k][e] * xv; }
                if (SILU) a = a * sigmoidf(a);
                out[j][4 * hf + e] = a * rs;
            }
        }
    }
    if (TRANS) {
#pragma unroll
        for (int e = 0; e < 8; ++e) {
            if (ROWS == 4) { u32x2 wv; wv.x = pk2(out[0][e], out[1][e]); wv.y = pk2(out[ROWS - 2][e], out[ROWS - 1][e]); *(u32x2*)(dst + (size_t)(ch * 8 + e) * RS + rg * 8) = wv; }
            else { *(unsigned*)(dst + (size_t)(ch * 8 + e) * RS + rg * 4) = pk2(out[0][e], out[1][e]); }
        }
    } else {
#pragma unroll
        for (int j = 0; j < ROWS; ++j) { u32x4 wv; wv.x = pk2(out[j][0], out[j][1]); wv.y = pk2(out[j][2], out[j][3]); wv.z = pk2(out[j][4], out[j][5]); wv.w = pk2(out[j][6], out[j][7]);
            *(u32x4*)(dst + (size_t)(rg * ROWS + j) * RS + ch * 16) = wv; }
    }
}

constexpr int R272 = 272;
__device__ __forceinline__ void ssd_dt_acum(const Params& P, float* s_dt, float* s_ac, int tok0, int g, int tid) {
    const float* dtraw = (const float*)(P.ws + WS_DT);
#pragma unroll
    for (int i = 0; i < 2; ++i) { const int idx = tid + 512 * i, hh = idx >> 7, l = idx & 127, hd = g * 8 + hh;
        s_dt[idx] = softplusf(dtraw[(size_t)(tok0 + l) * 16 + hd] + P.in[5][hd]); }
    __syncthreads();
#pragma unroll
    for (int i = 0; i < 2; ++i) { const int idx = tid + 512 * i, hh = idx >> 7, l = idx & 127, hd = g * 8 + hh;
        const float a = -expf(P.in[6][hd]); float s = 0.f;
        for (int q = 0; q <= l; ++q) s += s_dt[hh * 128 + q] * a;
        s_ac[idx] = s; }
    __syncthreads();
}

__device__ __forceinline__ void ssd_A_unit(const Params& P, unsigned char* lds, int b, int c, int g) {
    const int tid = opaque_tid(), lane = tid & 63, r32 = lane & 31, hi = lane >> 5, w = tid >> 6;
    unsigned char* BT = lds; unsigned char* XsT = lds + 34816;
    float* s_dt = (float*)(lds + 52224); float* s_ac = (float*)(lds + 56320); float* s_rs = (float*)(lds + 60416);
    const int tok0 = b * SEQ + c * 128;
    const u16* XBC = (const u16*)(P.ws + WS_XBC);
    ssd_dt_acum(P, s_dt, s_ac, tok0, g, tid);
    conv_tile<16, 4, true, true>(XBC, 1536, 1024 + g * 128, P.in[3], P.in[4], 1536, (size_t)b * SEQ, c * 128, BT, R272, nullptr, tid);
    for (int hh = 0; hh < 8; ++hh) {
        const int hd = g * 8 + hh;
        __syncthreads();
        if (tid < 128) s_rs[tid] = s_dt[hh * 128 + tid] * fexp(s_ac[hh * 128 + 127] - s_ac[hh * 128 + tid]);
        __syncthreads();
        conv_tile<8, 2, true, true>(XBC, 1536, hd * 64, P.in[3], P.in[4], 1536, (size_t)b * SEQ, c * 128, XsT, R272, s_rs, tid);
        __syncthreads();
        const int mi = w >> 2, ni = w & 3;
        f32x16 acc = zero16();
#pragma unroll
        for (int k0 = 0; k0 < 8; ++k0) {
            const bf16x8 a = *(const bf16x8*)(XsT + (32 * mi + r32) * R272 + (16 * k0 + 8 * hi) * 2);
            const bf16x8 bb = *(const bf16x8*)(BT + (32 * ni + r32) * R272 + (16 * k0 + 8 * hi) * 2);
            acc = mfma32(a, bb, acc);
        }
        float* sp = P.out + ((size_t)(b * 64 + c) * 16 + hd) * 8192;
#pragma unroll
        for (int r = 0; r < 16; ++r) sp[(32 * mi + crow(r, hi)) * 128 + 32 * ni + r32] = acc[r];
        if (tid == 0) ((float*)(P.ws + WS_CDEC))[(b * 64 + c) * 16 + hd] = expf(s_ac[hh * 128 + 127]);
    }
    __syncthreads();
}

__device__ __forceinline__ void ssd_C_unit(const Params& P, unsigned char* lds, int b, int c, int g, u16* Y, int ldy) {
    const int tid = opaque_tid(), lane = tid & 63, r32 = lane & 31, hi = lane >> 5, w = tid >> 6;
    unsigned char* Cs = lds; unsigned char* Ms = lds + 34816; unsigned char* Ps = lds + 69632; unsigned char* Xt = lds + 87040;
    float* s_dt = (float*)(lds + 104448); float* s_ac = (float*)(lds + 108544); float* s_ssq = (float*)(lds + 112640);
    const int tok0 = b * SEQ + c * 128;
    const u16* XBC = (const u16*)(P.ws + WS_XBC); u16* ZG = (u16*)(P.ws + WS_ZG);
    if (tid < 128) s_ssq[tid] = 0.f;
    ssd_dt_acum(P, s_dt, s_ac, tok0, g, tid);
    conv_tile<16, 4, true, false>(XBC, 1536, 1280 + g * 128, P.in[3], P.in[4], 1536, (size_t)b * SEQ, c * 128, Cs, R272, nullptr, tid);
    conv_tile<16, 4, true, false>(XBC, 1536, 1024 + g * 128, P.in[3], P.in[4], 1536, (size_t)b * SEQ, c * 128, Ms, R272, nullptr, tid);
    __syncthreads();
    const int mi = w >> 1, nib = (w & 1) * 2;
    f32x16 cb[2];
#pragma unroll
    for (int t2 = 0; t2 < 2; ++t2) { const int ni = nib + t2; cb[t2] = zero16();
        if (ni <= mi) {
#pragma unroll
            for (int k0 = 0; k0 < 8; ++k0) {
                const bf16x8 a = *(const bf16x8*)(Cs + (32 * mi + r32) * R272 + (16 * k0 + 8 * hi) * 2);
                const bf16x8 bb = *(const bf16x8*)(Ms + (32 * ni + r32) * R272 + (16 * k0 + 8 * hi) * 2);
                cb[t2] = mfma32(a, bb, cb[t2]);
            } } }
    __syncthreads();
    unsigned cbp[2][8];
#pragma unroll
    for (int t2 = 0; t2 < 2; ++t2)
#pragma unroll
        for (int r = 0; r < 8; ++r) cbp[t2][r] = pk2(cb[t2][2 * r], cb[t2][2 * r + 1]);
    const int pt = w & 1;
#pragma unroll 1
    for (int hh = 0; hh < 8; ++hh) {
        const int hd = g * 8 + hh;
#pragma unroll
        for (int t2 = 0; t2 < 2; ++t2) { const int ni = nib + t2; const int s = 32 * ni + r32; const float acs = s_ac[hh * 128 + s], dts = s_dt[hh * 128 + s];
#pragma unroll
            for (int r = 0; r < 16; ++r) { const int l = 32 * mi + crow(r, hi);
                const float cbv = (r & 1) ? bfhi(cbp[t2][r >> 1]) : bflo(cbp[t2][r >> 1]);
                float v = 0.f; if (s <= l) v = cbv * fexp(s_ac[hh * 128 + l] - acs) * dts;
                *(u16*)(Ms + l * R272 + s * 2) = (u16)f2bf(v); } }
        conv_tile<8, 2, true, true>(XBC, 1536, hd * 64, P.in[3], P.in[4], 1536, (size_t)b * SEQ, c * 128, Xt, R272, nullptr, tid);
        { const float* sp = P.out + ((size_t)(b * 64 + c) * 16 + hd) * 8192;
#pragma unroll
            for (int i = 0; i < 4; ++i) { const int idx4 = tid + 512 * i, p = idx4 >> 5, n4 = (idx4 & 31) * 4; const f32x4 v = *(const f32x4*)(sp + p * 128 + n4);
                u32x2 wv; wv.x = pk2(v.x, v.y); wv.y = pk2(v.z, v.w); *(u32x2*)(Ps + p * R272 + n4 * 2) = wv; } }
        __syncthreads();
        f32x16 acc = zero16();
#pragma unroll
        for (int k0 = 0; k0 < 8; ++k0) {
            const bf16x8 a = *(const bf16x8*)(Cs + (32 * mi + r32) * R272 + (16 * k0 + 8 * hi) * 2);
            const bf16x8 bb = *(const bf16x8*)(Ps + (32 * pt + r32) * R272 + (16 * k0 + 8 * hi) * 2);
            acc = mfma32(a, bb, acc);
        }
#pragma unroll
        for (int r = 0; r < 16; ++r) acc[r] *= fexp(s_ac[hh * 128 + 32 * mi + crow(r, hi)]);
#pragma unroll
        for (int k0 = 0; k0 < 8; ++k0) {
            if (16 * k0 <= 32 * mi + 31) {
                const bf16x8 a = *(const bf16x8*)(Ms + (32 * mi + r32) * R272 + (16 * k0 + 8 * hi) * 2);
                const bf16x8 bb = *(const bf16x8*)(Xt + (32 * pt + r32) * R272 + (16 * k0 + 8 * hi) * 2);
                acc = mfma32(a, bb, acc);
            } }
        const float dsk = P.in[7][hd]; const int p = 32 * pt + r32;
#pragma unroll
        for (int r = 0; r < 16; ++r) { const int l = 32 * mi + crow(r, hi);
            const float xv = bf2f(*(const u16*)(Xt + p * R272 + l * 2));
            const float y = acc[r] + dsk * xv;
            u16* zp = Y + (size_t)(tok0 + l) * ldy + hd * 64 + p;
            const float z = bf2f(ZG[(size_t)(tok0 + l) * 2048 + hd * 64 + p]);
            const unsigned ygb = f2bf(y * z * sigmoidf(z));
            *zp = (u16)ygb;
            const float ygf = bf2f(ygb);
            float sq = ygf * ygf;
            sq += __shfl_xor(sq, 1); sq += __shfl_xor(sq, 2); sq += __shfl_xor(sq, 4); sq += __shfl_xor(sq, 8); sq += __shfl_xor(sq, 16);
            if (r32 == 0) atomicAdd(&s_ssq[l], sq); }
        __syncthreads();
    }
    float rs[16];
#pragma unroll
    for (int r = 0; r < 16; ++r) rs[r] = 1.f / sqrtf(s_ssq[32 * mi + crow(r, hi)] * (1.f / 512.f) + LN_EPS);
#pragma unroll 1
    for (int hh = 0; hh < 8; ++hh) { const int hd = g * 8 + hh, p = 32 * pt + r32; const float nw = P.in[8][hd * 64 + p];
#pragma unroll
        for (int r = 0; r < 16; ++r) { const int l = 32 * mi + crow(r, hi); u16* zp = Y + (size_t)(tok0 + l) * ldy + hd * 64 + p;
            const float yv = bf2f(*(volatile u16*)zp);
            *zp = (u16)f2bf(yv * rs[r] * nw); } }
    __syncthreads();
}

template <bool PHASE_C>
__device__ __forceinline__ void lru_unit(const Params& P, unsigned char* lds, int b, int c, int h, u16* Y, int ldy) {
    const int tid = opaque_tid(), lane = tid & 63, r32 = lane & 31, hi = lane >> 5, w = tid >> 6;
    unsigned char* Xs = lds; unsigned char* WaT = lds + 18432; unsigned char* WxT = lds + 27648;
    float* af = (float*)(lds + 36864); float* uf = (float*)(lds + 69632); float* segA = (float*)(lds + 102400); float* segH = (float*)(lds + 104448);
    const int tok0 = b * SEQ + c * 128;
    const u16* XL = (const u16*)(P.ws + WS_XL); u16* ZG = (u16*)(P.ws + WS_ZG);
    conv_tile<8, 2, false, false>(XL, 1024, h * 64, P.in[9], P.in[10], 1024, (size_t)b * SEQ, c * 128, Xs, 144, nullptr, tid);
    { const int i = tid >> 3, j0 = (tid & 7) * 8;
        const float* wa = P.in[11] + (size_t)h * 4096 + i * 64 + j0; const float* wx = P.in[13] + (size_t)h * 4096 + i * 64 + j0;
#pragma unroll
        for (int e4 = 0; e4 < 2; ++e4) { const f32x4 va = *(const f32x4*)(wa + 4 * e4), vx = *(const f32x4*)(wx + 4 * e4);
#pragma unroll
            for (int e = 0; e < 4; ++e) { *(u16*)(WaT + (j0 + 4 * e4 + e) * 144 + i * 2) = (u16)f2bf(va[e]); *(u16*)(WxT + (j0 + 4 * e4 + e) * 144 + i * 2) = (u16)f2bf(vx[e]); } } }
    __syncthreads();
    {
        const int mi = w >> 1, ni = w & 1;
        f32x16 accA = zero16(), accX = zero16();
#pragma unroll
        for (int k0 = 0; k0 < 4; ++k0) {
            const bf16x8 a = *(const bf16x8*)(Xs + (32 * mi + r32) * 144 + (16 * k0 + 8 * hi) * 2);
            const bf16x8 ba = *(const bf16x8*)(WaT + (32 * ni + r32) * 144 + (16 * k0 + 8 * hi) * 2);
            const bf16x8 bx = *(const bf16x8*)(WxT + (32 * ni + r32) * 144 + (16 * k0 + 8 * hi) * 2);
            accA = mfma32(a, ba, accA); accX = mfma32(a, bx, accX);
        }
        const int j = 32 * ni + r32, chn = h * 64 + j;
        const float ba_ = P.in[12][chn], bx_ = P.in[14][chn], sp = softplusf(-P.in[15][chn]);
#pragma unroll
        for (int r = 0; r < 16; ++r) { const int l = 32 * mi + crow(r, hi);
            const float rg = sigmoidf(accA[r] + ba_), ig = sigmoidf(accX[r] + bx_);
            const float la = -8.0f * rg * sp; const float a = fexp(la); const float x2 = 2.f * la;
            const float em = x2 > -0.25f ? -x2 * (1.f + x2 * (0.5f + x2 * (0.16666667f + x2 * (0.041666668f + x2 * (0.0083333338f + x2 * 0.0013888889f))))) : 1.f - fexp(x2);
            const float mult = __builtin_amdgcn_sqrtf(fmaxf(em, 0.f));
            const float xl = bf2f(*(const u16*)(Xs + l * 144 + j * 2));
            af[l * 64 + j] = a; uf[l * 64 + j] = mult * (ig * xl); }
    }
    __syncthreads();
    const int j = tid & 63, seg = tid >> 6, chn = h * 64 + j;
    float Pp = 1.f, hl = 0.f;
#pragma unroll
    for (int i = 0; i < 16; ++i) { const int l = seg * 16 + i; const float a = af[l * 64 + j]; hl = a * hl + uf[l * 64 + j]; Pp *= a;
        if (PHASE_C) { uf[l * 64 + j] = hl; af[l * 64 + j] = Pp; } }
    segA[seg * 64 + j] = Pp; segH[seg * 64 + j] = hl;
    __syncthreads();
    float cin = PHASE_C ? ((const float*)(P.ws + WS_LCH))[(size_t)(b * 64 + c) * 1024 + chn] : 0.f;
    float At = 1.f;
    for (int s = 0; s < seg; ++s) { const float a = segA[s * 64 + j]; cin = a * cin + segH[s * 64 + j]; At *= a; }
    if (!PHASE_C) {
        if (seg == 7) { ((float*)(P.ws + WS_LCA))[(size_t)(b * 64 + c) * 1024 + chn] = At * Pp; ((float*)(P.ws + WS_LCH))[(size_t)(b * 64 + c) * 1024 + chn] = Pp * cin + hl; }
    } else {
#pragma unroll
        for (int i = 0; i < 16; ++i) { const int l = seg * 16 + i; const float hv = uf[l * 64 + j] + af[l * 64 + j] * cin;
            u16* gp = Y + (size_t)(tok0 + l) * ldy + chn; const float gt = bf2f(ZG[(size_t)(tok0 + l) * 2048 + 1024 + chn]);
            const float u_ = 0.7978845608028654f * (gt + 0.044715f * gt * gt * gt); const float th = 1.f - 2.f * frcp(1.f + fexp(2.f * u_));
            *gp = (u16)f2bf(hv * 0.5f * gt * (1.f + th)); }
    }
    __syncthreads();
}

__device__ __forceinline__ void scan_phase(const Params& P) {
    const int gtid = blockIdx.x * 512 + opaque_tid(), NT_ = gridDim.x * 512;
    float* st = P.out; const float* cdec = (const float*)(P.ws + WS_CDEC);
    for (int e2 = gtid; e2 < 2 * 16 * 4096; e2 += NT_) {
        const int bh = e2 >> 12, b = bh >> 4, h = bh & 15, off = (e2 & 4095) * 2;
        f32x2 prev = (f32x2){0.f, 0.f};
        for (int c0 = 0; c0 < 64; c0 += 8) {
            f32x2 tmp[8]; float dec[8];
#pragma unroll
            for (int q = 0; q < 8; ++q) { tmp[q] = *(const f32x2*)(st + ((size_t)(b * 64 + c0 + q) * 16 + h) * 8192 + off); dec[q] = cdec[(b * 64 + c0 + q) * 16 + h]; }
#pragma unroll
            for (int q = 0; q < 8; ++q) { *(f32x2*)(st + ((size_t)(b * 64 + c0 + q) * 16 + h) * 8192 + off) = prev; prev = prev * dec[q] + tmp[q]; }
        }
    }
    if (gtid < 2048) {
        const int b = gtid >> 10, chn = gtid & 1023; float hin = 0.f;
        const float* cA = (const float*)(P.ws + WS_LCA); float* cH = (float*)(P.ws + WS_LCH);
        for (int c0 = 0; c0 < 64; c0 += 8) {
            float A_[8], H_[8];
#pragma unroll
            for (int q = 0; q < 8; ++q) { A_[q] = cA[(size_t)(b * 64 + c0 + q) * 1024 + chn]; H_[q] = cH[(size_t)(b * 64 + c0 + q) * 1024 + chn]; }
#pragma unroll
            for (int q = 0; q < 8; ++q) { cH[(size_t)(b * 64 + c0 + q) * 1024 + chn] = hin; hin = A_[q] * hin + H_[q]; }
        }
    }
}

namespace att {
constexpr int KROW = 272, VROW = 136, KBYTES = 64 * KROW, VBYTES = 128 * VROW, BUF = KBYTES + VBYTES;
__device__ __forceinline__ void attn_unit(unsigned char* lds, const u16* QK, const u16* Vt, u16* O, const float* subln, float lam, int b, int h, int qb) {
    const int tid = opaque_tid(), lane = tid & 63, r32 = lane & 31, hi = lane >> 5, w = tid >> 6, qg = w >> 1, c = w & 1;
    const int q0 = qb * 128, qw = q0 + 32 * qg;
    const size_t rowbase = (size_t)b * SEQ;
    bf16x8 qf[4];
    { const u16* qp = QK + (rowbase + qw + r32) * 2048 + h * 128 + c * 64 + 8 * hi;
#pragma unroll
      for (int d0 = 0; d0 < 4; ++d0) qf[d0] = *(const bf16x8*)(qp + d0 * 16); }
    f32x16 o[4];
#pragma unroll
    for (int dt = 0; dt < 4; ++dt) o[dt] = zero16();
    float mrun = -1e30f, lrun = 0.f;
    const int NT = 2 * (qb + 1);
    const int krow = tid >> 4, kch = tid & 15, vrow = tid >> 3, vch = tid & 7;
    const u16* kg = QK + (rowbase + krow) * 2048 + 1024 + h * 128 + kch * 8;
    const u16* vg = Vt + (size_t)(h * 128 + vrow) * T + rowbase + vch * 8;
    u32x4 kr[2], vr[2];
#define ATT_LOAD(t) do { kr[0] = *(const u32x4*)(kg + (size_t)(t) * 64 * 2048); kr[1] = *(const u32x4*)(kg + (size_t)(t) * 64 * 2048 + 32 * 2048); \
                         vr[0] = *(const u32x4*)(vg + (size_t)(t) * 64); vr[1] = *(const u32x4*)(vg + (size_t)(t) * 64 + (size_t)64 * T); } while (0)
#define ATT_STORE(bufp) do { unsigned char* kb_ = (bufp); unsigned char* vb_ = kb_ + KBYTES; \
        *(u32x4*)(kb_ + krow * KROW + kch * 16) = kr[0]; *(u32x4*)(kb_ + (krow + 32) * KROW + kch * 16) = kr[1]; \
        *(u32x2*)(vb_ + vrow * VROW + vch * 16) = (u32x2){vr[0].x, vr[0].y}; *(u32x2*)(vb_ + vrow * VROW + vch * 16 + 8) = (u32x2){vr[0].z, vr[0].w}; \
        *(u32x2*)(vb_ + (vrow + 64) * VROW + vch * 16) = (u32x2){vr[1].x, vr[1].y}; *(u32x2*)(vb_ + (vrow + 64) * VROW + vch * 16 + 8) = (u32x2){vr[1].z, vr[1].w}; } while (0)
    ATT_LOAD(0); ATT_STORE(lds); __syncthreads();
    for (int t = 0; t < NT; ++t) {
        const unsigned char* kb = lds + (t & 1) * BUF; const unsigned char* vb = kb + KBYTES;
        if (t + 1 < NT) ATT_LOAD(t + 1);
        if (64 * t <= qw + 31) {
            bf16x8 pb[4];
            bf16x8 kf0[4], kf1[4];
#pragma unroll
            for (int d0 = 0; d0 < 4; ++d0) {
                kf0[d0] = *(const bf16x8*)(kb + r32 * KROW + (c * 64 + d0 * 16 + 8 * hi) * 2);
                kf1[d0] = *(const bf16x8*)(kb + (32 + r32) * KROW + (c * 64 + d0 * 16 + 8 * hi) * 2);
            }
            f32x16 p0 = zero16(), p1 = zero16();
#pragma unroll
            for (int d0 = 0; d0 < 4; ++d0) { p0 = mfma32(kf0[d0], qf[d0], p0); p1 = mfma32(kf1[d0], qf[d0], p1); }
            u32x2 vlo[8], vhi[8];
#define ATT_VLD(i, dt, s) do { const unsigned char* ap_ = vb + (32 * (dt) + r32) * VROW + (16 * (s) + 4 * hi) * 2; vlo[i] = *(const u32x2*)ap_; vhi[i] = *(const u32x2*)(ap_ + 16); } while (0)
#define ATT_VF(i) __builtin_bit_cast(bf16x8, (u32x4){vlo[i].x, vlo[i].y, vhi[i].x, vhi[i].y})
#pragma unroll
            for (int i = 0; i < 8; ++i) ATT_VLD(i, i >> 2, i & 3);
            __builtin_amdgcn_sched_barrier(0);
            {
                if (64 * t + 63 > qw) {
                    const int qgl = qw + r32;
#pragma unroll
                    for (int r = 0; r < 16; ++r) { const int kv = 64 * t + crow(r, hi); if (kv > qgl) p0[r] = -INFINITY; if (kv + 32 > qgl) p1[r] = -INFINITY; }
                }
                float mx = fmaxf(p0[0], p1[0]);
#pragma unroll
                for (int r = 1; r < 16; ++r) mx = fmaxf(mx, fmaxf(p0[r], p1[r]));
                mx = fmaxf(mx, __shfl_xor(mx, 32));
                const float mn = fmaxf(mrun, mx); const float f = __builtin_amdgcn_exp2f(mrun - mn); mrun = mn;
                float sum = 0.f;
#pragma unroll
                for (int r = 0; r < 16; ++r) { p0[r] = __builtin_amdgcn_exp2f(p0[r] - mn); p1[r] = __builtin_amdgcn_exp2f(p1[r] - mn); sum += p0[r] + p1[r]; }
                lrun = lrun * f + sum;
                if (__builtin_amdgcn_ballot_w64(f != 1.0f) != 0ull) {
#pragma unroll
                    for (int dt = 0; dt < 4; ++dt)
#pragma unroll
                        for (int r = 0; r < 16; ++r) o[dt][r] *= f;
                }
#pragma unroll
                for (int s = 0; s < 2; ++s) {
                    u32x4 a, bq;
                    a.x = pk2(p0[8 * s + 0], p0[8 * s + 1]); a.y = pk2(p0[8 * s + 2], p0[8 * s + 3]); a.z = pk2(p0[8 * s + 4], p0[8 * s + 5]); a.w = pk2(p0[8 * s + 6], p0[8 * s + 7]);
                    bq.x = pk2(p1[8 * s + 0], p1[8 * s + 1]); bq.y = pk2(p1[8 * s + 2], p1[8 * s + 3]); bq.z = pk2(p1[8 * s + 4], p1[8 * s + 5]); bq.w = pk2(p1[8 * s + 6], p1[8 * s + 7]);
                    pb[s] = __builtin_bit_cast(bf16x8, a); pb[2 + s] = __builtin_bit_cast(bf16x8, bq);
                }
            }
            __builtin_amdgcn_sched_barrier(0);
#pragma unroll
            for (int i = 0; i < 8; ++i) {
                const bf16x8 vf = ATT_VF(i);
                o[i >> 2] = mfma32(vf, pb[i & 3], o[i >> 2]);
                ATT_VLD(i, 2 + (i >> 2), i & 3);
            }
            __builtin_amdgcn_sched_barrier(0);
#pragma unroll
            for (int i = 0; i < 8; ++i) { const bf16x8 vf = ATT_VF(i); o[2 + (i >> 2)] = mfma32(vf, pb[i & 3], o[2 + (i >> 2)]); }
#undef ATT_VLD
#undef ATT_VF
        }
        if (t + 1 < NT) ATT_STORE(lds + ((t + 1) & 1) * BUF);
        __syncthreads();
    }
#undef ATT_LOAD
#undef ATT_STORE
    const float lt = lrun + __shfl_xor(lrun, 32);
    float* xb = (float*)lds + qg * 4096;
    if (c == 1) { const float inv = lam / lt;
#pragma unroll
        for (int dt = 0; dt < 4; ++dt)
#pragma unroll
            for (int r = 0; r < 16; ++r) xb[(32 * dt + crow(r, hi)) * 32 + r32] = o[dt][r] * inv; }
    __syncthreads();
    if (c == 0) {
        const float inv = 1.f / lt; float ssq = 0.f;
#pragma unroll
        for (int dt = 0; dt < 4; ++dt)
#pragma unroll
            for (int r = 0; r < 16; ++r) { const float v = o[dt][r] * inv - xb[(32 * dt + crow(r, hi)) * 32 + r32]; o[dt][r] = v; ssq += v * v; }
        ssq += __shfl_xor(ssq, 32);
        const float rstd = (1.f - LAMBDA_INIT) / sqrtf(ssq * (1.f / 128.f) + LN_EPS);
        u16* op = O + (rowbase + qw + r32) * 1024 + h * 128;
#pragma unroll
        for (int dt = 0; dt < 4; ++dt)
#pragma unroll
            for (int g4 = 0; g4 < 4; ++g4) { const int d = 32 * dt + 8 * g4 + 4 * hi; const f32x4 sw = *(const f32x4*)(subln + d);
                u32x2 wv; wv.x = pk2(o[dt][4 * g4 + 0] * rstd * sw.x, o[dt][4 * g4 + 1] * rstd * sw.y); wv.y = pk2(o[dt][4 * g4 + 2] * rstd * sw.z, o[dt][4 * g4 + 3] * rstd * sw.w);
                *(u32x2*)(op + d) = wv; }
    }
    __syncthreads();
}
}

__device__ __forceinline__ void attn_phase(const Params& P, unsigned char* lds) {
    float s1 = 0.f, s2 = 0.f;
    for (int i = 0; i < 64; ++i) { s1 += P.in[18][i] * P.in[19][i]; s2 += P.in[20][i] * P.in[21][i]; }
    const float lam = expf(s1) - expf(s2) + LAMBDA_INIT;
    const u16* QK = (const u16*)(P.ws + WS_QK); const u16* Vt = (const u16*)(P.ws + WS_VT); u16* O = (u16*)(P.ws + WS_O);
    const int G_ = gridDim.x, vcu = (G_ % 8 == 0) ? ((int)blockIdx.x % 8) * (G_ / 8) + (int)blockIdx.x / 8 : (int)blockIdx.x;
    for (int p = vcu; p < 512; p += G_) {
        const int bh = p >> 5, s = p & 31, b = bh >> 3, h = bh & 7;
        att::attn_unit(lds, QK, Vt, O, P.in[22], lam, b, h, 63 - s);
        att::attn_unit(lds, QK, Vt, O, P.in[22], lam, b, h, s);
    }
}

#define LAS __attribute__((address_space(3)))
#define XB_TMO      128
#define XB_XCNT(j)  (256  + 64 * (j))
#define XB_XSUB(j)  (1280 + 64 * (j))
#define XB_XGEN(j)  (2304 + 64 * (j))
#define XB_TOP      3328
#define XB_TOPGEN   3392
#define XCD_BAR_WORDS 3456
#define XB_SPIN_CAP (1u << 18)

__device__ __forceinline__ unsigned xb_ld(unsigned* p)              { return __hip_atomic_load(p, __ATOMIC_RELAXED, __HIP_MEMORY_SCOPE_AGENT); }
__device__ __forceinline__ unsigned xb_add(unsigned* p, unsigned v) { return __hip_atomic_fetch_add(p, v, __ATOMIC_RELAXED, __HIP_MEMORY_SCOPE_AGENT); }
__device__ __forceinline__ unsigned xb_xcc_id() { return (unsigned)__builtin_amdgcn_s_getreg((3 << 11) | 20) & 0xFu; }
#define XB_SPIN(cond, bar) do { unsigned _sp = 0; while (cond) { __builtin_amdgcn_s_sleep(1); \
    if ((++_sp & 255u) == 0u) { if (xb_ld(&(bar)[XB_TMO])) break; if (_sp > XB_SPIN_CAP) { atomicAdd(&(bar)[XB_TMO], 1u); break; } } } } while (0)

struct XcdBarrier {
    unsigned* bar; unsigned x;
    volatile LAS unsigned* st;
};

__device__ __forceinline__ XcdBarrier xcd_barrier_post(unsigned* bar, volatile LAS unsigned* st) {
    XcdBarrier b; b.bar = bar; b.x = xb_xcc_id(); b.st = st;
    if (threadIdx.x == 0) (void)xb_add(&bar[XB_XCNT(b.x)], 1u);
    return b;
}
__device__ __forceinline__ void xcd_barrier_complete(unsigned* bar, unsigned x, unsigned& nloc, unsigned& nx) {
    const unsigned G = gridDim.x * gridDim.y * gridDim.z;
    unsigned sum, cnt, mine, sp = 0u;
    for (;;) {
        sum = 0u; cnt = 0u; mine = 0u;
#pragma unroll
        for (unsigned j = 0; j < 16; ++j) { const unsigned c = xb_ld(&bar[XB_XCNT(j)]); sum += c; cnt += (c > 0u) ? 1u : 0u; mine = (j == x) ? c : mine; }
        if (sum == G) break;
        __builtin_amdgcn_s_sleep(1);
        if ((++sp & 255u) == 0u) { if (xb_ld(&bar[XB_TMO])) break; if (sp > XB_SPIN_CAP) { atomicAdd(&bar[XB_TMO], 1u); break; } }
    }
    nloc = mine > 0u ? mine : 1u; nx = cnt > 0u ? cnt : 1u;
}

__device__ __forceinline__ void xcd_barrier(const XcdBarrier& b) {
    asm volatile("s_waitcnt vmcnt(0)" ::: "memory");
    __syncthreads();
    if (threadIdx.x == 0) {
        unsigned* bar = b.bar;
        __builtin_amdgcn_s_waitcnt(0);
        unsigned nloc = b.st[0], nx = b.st[1];
        if (nloc == 0u) { xcd_barrier_complete(bar, b.x, nloc, nx); b.st[0] = nloc; b.st[1] = nx; }
        const unsigned old = xb_add(&bar[XB_XSUB(b.x)], 1u);
        const unsigned gen = old / nloc;
        if (old + 1u == (gen + 1u) * nloc) {
            __builtin_amdgcn_fence(__ATOMIC_RELEASE, "agent");
            asm volatile("s_waitcnt vmcnt(0)" ::: "memory");
            const unsigned og = xb_add(&bar[XB_TOP], 1u);
            const unsigned tg = og / nx;
            if (og + 1u == (tg + 1u) * nx) xb_add(&bar[XB_TOPGEN], 1u);
            else XB_SPIN(xb_ld(&bar[XB_TOPGEN]) == tg, bar);
            __builtin_amdgcn_fence(__ATOMIC_ACQUIRE, "agent");
            xb_add(&bar[XB_XGEN(b.x)], 1u);
            asm volatile("s_waitcnt vmcnt(0)" ::: "memory");
        } else {
            XB_SPIN(xb_ld(&bar[XB_XGEN(b.x)]) == gen, bar);
            __builtin_amdgcn_fence(__ATOMIC_ACQUIRE, "agent");
            asm volatile("s_waitcnt vmcnt(0)" ::: "memory");
        }
    }
    __syncthreads();
}

__global__ void __launch_bounds__(512) hybrid_fwd(Params P) {
    extern __shared__ __attribute__((aligned(16))) unsigned char lds[];
    cg::grid_group grid = cg::this_grid();
    unsigned char* ws = P.ws;
    const int G = gridDim.x, bx = blockIdx.x;
    u16* XB = (u16*)(ws + WS_XB); u16* ZG = (u16*)(ws + WS_ZG); u16* HB = (u16*)(ws + WS_H);

#ifndef PHM
#define PHM 0xffff
#endif
#ifndef DBLM
#define DBLM 0
#endif
#define PH(n) for (int rep_ = 0; rep_ < (((DBLM) >> (n)) & 1) + 1; ++rep_) if (PHM & (1 << (n)))
    unsigned* barw = (unsigned*)(ws + WS_BAR);
    volatile LAS unsigned* MISC = (volatile LAS unsigned*)((LAS unsigned char*)lds + MISC_OFF);
    if (threadIdx.x < 2) MISC[threadIdx.x] = 0u;
    __syncthreads();
    PH(0) prologue(P, lds);
    grid.sync();
    XcdBarrier xbar = xcd_barrier_post(barw, MISC);
#define GSYNC() xcd_barrier(xbar)
    PH(1) { Epi<0> E{ZG, (u16*)(ws + WS_XBC), (u16*)(ws + WS_XL), (float*)(ws + WS_DT), nullptr, 0};
      run_gemm<0>(lds, XB, (const u16*)(ws + WS_WIN), T, NIN, D, E); }
    GSYNC();
    PH(2) for (int u = bx; u < 256; u += G) ssd_A_unit(P, lds, u >> 7, (u >> 1) & 63, u & 1);
    PH(3) for (int u = bx; u < 2048; u += G) lru_unit<false>(P, lds, u >> 10, (u >> 4) & 63, u & 15, nullptr, 0);
    GSYNC();
#ifdef PROBE_SYNC
    for (int i_ = 0; i_ < 10; ++i_) GSYNC();
#endif
#ifdef PROBE_SCAN
    if (0)
#endif
    PH(4) scan_phase(P);
    GSYNC();
#ifdef PROBE_SSDC
    for (int u = bx; u < 256; u += G) ssd_C_unit(P, lds, u >> 7, (u >> 1) & 63, u & 1, XB, 1024);
#endif
#ifdef PROBE_LRUC
    for (int u = bx; u < 2048; u += G) lru_unit<true>(P, lds, u >> 10, (u >> 4) & 63, u & 15, XB, 1024);
#endif
    PH(5) for (int u = bx; u < 256; u += G) ssd_C_unit(P, lds, u >> 7, (u >> 1) & 63, u & 1, ZG, 2048);
    PH(6) for (int u = bx; u < 2048; u += G) lru_unit<true>(P, lds, u >> 10, (u >> 4) & 63, u & 15, ZG + 1024, 2048);
    GSYNC();
    PH(7) { Epi<1> E{nullptr, nullptr, nullptr, P.out, P.in[0], 0};
      run_gemm<1>(lds, ZG, (const u16*)(ws + WS_WOUT), T, D, 2048, E); }
    GSYNC();
    PH(8) ln_phase(P.out, P.in[24], P.in[25], P.out, XB);
    GSYNC();
    PH(9) { Epi<2> E{HB, nullptr, nullptr, nullptr, nullptr, FF};
      run_gemm<2>(lds, XB, (const u16*)(ws + WS_W1), T, FF, D, E); }
    GSYNC();
    { Epi<1> E{nullptr, nullptr, nullptr, P.out, P.out, 0};
      run_gemm<1>(lds, HB, (const u16*)(ws + WS_W2), T, D, FF, E); }
    GSYNC();
    ln_phase(P.out, P.in[28], P.in[29], P.out, XB);
    GSYNC();
    PH(10) { Epi<3> E{(u16*)(ws + WS_QK), nullptr, nullptr, nullptr, (const float*)(ws + WS_ROPE), 0};
      run_gemm<3>(lds, XB, (const u16*)(ws + WS_WQKV), T, 2048, D, E); }
    PH(11) { Epi<4> E{(u16*)(ws + WS_VT), nullptr, nullptr, nullptr, nullptr, T};
      run_gemm<4>(lds, (const u16*)(ws + WS_WQKV) + (size_t)2048 * D, XB, D, T, D, E); }
    GSYNC();
    PH(12) attn_phase(P, lds);
    GSYNC();
    { Epi<1> E{nullptr, nullptr, nullptr, P.out, P.out, 0};
      run_gemm<1>(lds, (const u16*)(ws + WS_O), (const u16*)(ws + WS_WAO), T, D, D, E); }
    GSYNC();
    ln_phase(P.out, P.in[24] + D, P.in[25] + D, P.out, XB);
    GSYNC();
    { Epi<2> E{HB, nullptr, nullptr, nullptr, nullptr, FF};
      run_gemm<2>(lds, XB, (const u16*)(ws + WS_W1) + (size_t)FF * D, T, FF, D, E); }
    GSYNC();
    { Epi<1> E{nullptr, nullptr, nullptr, P.out, P.out, 0};
      run_gemm<1>(lds, HB, (const u16*)(ws + WS_W2) + (size_t)FF * D, T, D, FF, E); }
    GSYNC();
    ln_phase(P.out, P.in[28] + D, P.in[29] + D, P.out, nullptr);
}

extern "C" void kernel_launch(void* const* d_in, const int* in_sizes, int n_in, void* d_out, int out_size, void* d_ws, size_t ws_size, hipStream_t stream) {
    static int grid = 0;
    if (grid == 0) {
        if (n_in != 30 || in_sizes[0] != T * D || out_size != T * D || ws_size < WS_END) { fprintf(stderr, "kernel_launch: unexpected shapes (n_in %d in0 %d out %d ws %zu)\n", n_in, n_in > 0 ? in_sizes[0] : -1, out_size, ws_size); grid = -1; return; }
        int dev = 0, cus = 0, per_cu = 0;
        hipGetDevice(&dev); hipDeviceGetAttribute(&cus, hipDeviceAttributeMultiprocessorCount, dev);
        hipFuncSetAttribute((const void*)hybrid_fwd, hipFuncAttributeMaxDynamicSharedMemorySize, LDS_BYTES);
        hipOccupancyMaxActiveBlocksPerMultiprocessor(&per_cu, (const void*)hybrid_fwd, 512, LDS_BYTES);
        if (per_cu < 1) { fprintf(stderr, "kernel_launch: occupancy query says %d blocks per CU\n", per_cu); per_cu = 1; }
        (void)hipGetLastError();
        grid = cus;
    }
    if (grid < 0) return;
    if (hipMemsetAsync((char*)d_ws + WS_BAR, 0, 16384, stream) != hipSuccess) { fprintf(stderr, "kernel_launch: memset of the barrier words failed\n"); return; }
    Params p{};
    for (int i = 0; i < 30; ++i) p.in[i] = (const float*)d_in[i];
    p.out = (float*)d_out; p.ws = (unsigned char*)d_ws;
    void* args[] = {&p};
    hipError_t e = hipLaunchCooperativeKernel((const void*)hybrid_fwd, dim3(grid), dim3(512), args, LDS_BYTES, stream);
    if (e != hipSuccess) fprintf(stderr, "cooperative launch failed: %s (grid %d)\n", hipGetErrorString(e), grid);
}
```
